# Optimizing an MI355X kernel written in HIP

```python
import jax, jax.numpy as jnp
from jax import lax
import numpy as np


D_MODEL = 1024
BATCH = 16
SEQ = 2048
DEPTH = 2

CHUNK = 64
D_MIX = D_MODEL
A_DIM = D_MIX // 4
A_HEADS = 4
A_HEAD_DIM = A_DIM // A_HEADS
GMLP_BLOCK = 128
B_HEADS = 4
B_DV = (D_MIX // 2) // B_HEADS
B_DK = B_DV // 2
B_KDIM = B_HEADS * B_DK
B_VDIM = B_HEADS * B_DV
GLA_RANK = 16
GLA_TAU = 16.0
C_DIM = D_MIX - A_DIM - B_VDIM
CONV_WIDTH = 3
P_SIZES = (2 * A_DIM, B_KDIM, B_KDIM, B_VDIM, GLA_RANK, B_VDIM, C_DIM, C_DIM, C_DIM)
P_IN = sum(P_SIZES)
P_SPLITS = tuple(int(s) for s in np.cumsum(P_SIZES)[:-1])
N_EXPERTS = 32
N_GROUPS = 4
EXPERTS_PER_GROUP = N_EXPERTS // N_GROUPS
TOP_K = 2
D_FF_EXPERT = 512
EXPERT_BLOCK = 128
EPS = 1e-6

kernel_name = 'hybrid_gmlp_gla_shortconv_groupmoe_adaln'


def rmsnorm(x, g):
    xf = x.astype(jnp.float32)
    y = xf * lax.rsqrt(jnp.mean(xf * xf, axis=-1, keepdims=True) + EPS)
    return (y * g.astype(jnp.float32)).astype(x.dtype)


def spatial_gating(u, v, ln_g, ln_b, w_s, b_s):
    Bn, T, _ = v.shape
    vf = v.astype(jnp.float32)
    mu = jnp.mean(vf, axis=-1, keepdims=True)
    var = jnp.mean((vf - mu) ** 2, axis=-1, keepdims=True)
    vn = ((vf - mu) * lax.rsqrt(var + EPS) * ln_g.astype(jnp.float32) + ln_b.astype(jnp.float32)).astype(v.dtype)
    vn = vn.reshape(Bn, T // GMLP_BLOCK, GMLP_BLOCK, A_HEADS, A_HEAD_DIM)
    pos_chunk = jnp.arange(GMLP_BLOCK) // CHUNK
    mask = pos_chunk[:, None] >= pos_chunk[None, :]
    w = jnp.where(mask, w_s, 0).astype(vn.dtype)
    sv = jnp.einsum('hts,bnshd->bnthd', w, vn) + b_s.T[:, :, None].astype(vn.dtype)
    return u * sv.reshape(Bn, T, A_DIM)


def gla_chunked(q, k, v, glog):
    Bn, T, H, DK = q.shape
    DV = v.shape[-1]
    nC = T // CHUNK
    qf = q.astype(jnp.float32).reshape(Bn, nC, CHUNK, H, DK)
    kf = k.astype(jnp.float32).reshape(Bn, nC, CHUNK, H, DK)
    vf = v.astype(jnp.float32).reshape(Bn, nC, CHUNK, H, DV)
    b = jnp.cumsum(glog.astype(jnp.float32).reshape(Bn, nC, CHUNK, H, DK), axis=2)
    b_ref = b[:, :, CHUNK // 2:CHUNK // 2 + 1]
    b_last = b[:, :, CHUNK - 1:CHUNK]
    scores = jnp.einsum('bnihk,bnjhk->bnhij', qf * jnp.exp(b - b_ref), kf * jnp.exp(b_ref - b))
    causal = jnp.tril(jnp.ones((CHUNK, CHUNK), dtype=bool))
    scores = jnp.where(causal, scores, 0.0)
    o_intra = jnp.einsum('bnhij,bnjhv->bnihv', scores, vf)
    kv = jnp.einsum('bnjhk,bnjhv->bnhkv', kf * jnp.exp(b_last - b), vf)
    decay = jnp.exp(b_last[:, :, 0])

    def step(S, inp):
        dec, kv_c = inp
        return dec[..., None] * S + kv_c, S

    S0 = jnp.zeros((Bn, H, DK, DV), jnp.float32)
    _, S_prev = lax.scan(step, S0, (decay.transpose(1, 0, 2, 3), kv.transpose(1, 0, 2, 3, 4)))
    S_prev = S_prev.transpose(1, 0, 2, 3, 4)
    o_inter = jnp.einsum('bnihk,bnhkv->bnihv', qf * jnp.exp(b), S_prev)
    return (o_intra + o_inter).reshape(Bn, T, H, DV).astype(q.dtype)


def short_conv_mixer(gate_b, gate_c, xin, conv_w, conv_b):
    T = xin.shape[1]
    z = gate_c * xin
    zp = jnp.pad(z, ((0, 0), (CONV_WIDTH - 1, 0), (0, 0)))
    y = conv_b
    for j in range(CONV_WIDTH):
        y = y + conv_w[j] * zp[:, j:j + T]
    return gate_b * y


def hybrid_mixer(h, w_in, w_out, ln_g, ln_b, w_s, b_s, w_gate, b_gate, gla_g, conv_w, conv_b):
    Bn, T, _ = h.shape
    p = h @ w_in
    a_uv, q, k, v, g_lr, og, cb, cc, cx = jnp.split(p, P_SPLITS, axis=-1)
    u, vv = jnp.split(jax.nn.gelu(a_uv, approximate=False), 2, axis=-1)
    y_a = spatial_gating(u, vv, ln_g, ln_b, w_s, b_s)
    glog = jax.nn.log_sigmoid((g_lr @ w_gate + b_gate).astype(jnp.float32)) / GLA_TAU
    o = gla_chunked(q.reshape(Bn, T, B_HEADS, B_DK) * (B_DK ** -0.5),
                    k.reshape(Bn, T, B_HEADS, B_DK),
                    v.reshape(Bn, T, B_HEADS, B_DV),
                    glog.reshape(Bn, T, B_HEADS, B_DK))
    of = o.astype(jnp.float32)
    on = of * lax.rsqrt(jnp.mean(of * of, axis=-1, keepdims=True) + EPS)
    y_b = (on.reshape(Bn, T, B_VDIM) * gla_g.astype(jnp.float32)).astype(h.dtype) * jax.nn.silu(og)
    y_c = short_conv_mixer(cb, cc, cx, conv_w, conv_b)
    return jnp.concatenate([y_a, y_b, y_c], axis=-1) @ w_out


def moe(h, router_w, router_b, w1, w3, w2):
    Bn, T, D = h.shape
    N = Bn * T
    xt = h.reshape(N, D)
    logits = xt.astype(jnp.float32) @ router_w.astype(jnp.float32) + router_b.astype(jnp.float32)
    probs = jax.nn.softmax(logits, axis=-1)
    pg = probs.reshape(N, N_GROUPS, EXPERTS_PER_GROUP)
    gscore = jnp.sum(lax.top_k(pg, 2)[0], axis=-1)
    gidx = lax.top_k(gscore, 1)[1]
    in_group = jnp.take_along_axis(pg, gidx[:, :, None], axis=1)[:, 0]
    top_p, local = lax.top_k(in_group, TOP_K)
    experts = gidx * EXPERTS_PER_GROUP + local
    weights = top_p / jnp.sum(top_p, axis=-1, keepdims=True)
    A = N * TOP_K
    flat_e = experts.reshape(A)
    order = jnp.argsort(flat_e)
    sorted_e = flat_e[order]
    counts = jnp.bincount(flat_e, length=N_EXPERTS)
    padded = ((counts + EXPERT_BLOCK - 1) // EXPERT_BLOCK) * EXPERT_BLOCK
    pad_end = jnp.cumsum(padded)
    pad_start = pad_end - padded
    start = jnp.cumsum(counts) - counts
    dest = pad_start[sorted_e] + (jnp.arange(A) - start[sorted_e])
    n_blocks = -(-A // EXPERT_BLOCK) + N_EXPERTS
    xs = jnp.zeros((n_blocks * EXPERT_BLOCK, D), h.dtype).at[dest].set(xt[order // TOP_K])
    block_e = jnp.minimum(jnp.searchsorted(pad_end, jnp.arange(n_blocks) * EXPERT_BLOCK, side='right'),
                          N_EXPERTS - 1)

    def expert_block(args):
        xb, e = args
        return (jax.nn.silu(xb @ w1[e]) * (xb @ w3[e])) @ w2[e]

    ys = lax.map(expert_block, (xs.reshape(n_blocks, EXPERT_BLOCK, D), block_e)).reshape(-1, D)
    y_assign = jnp.zeros((A, D), h.dtype).at[order].set(ys[dest]).reshape(N, TOP_K, D)
    out = jnp.einsum('nk,nkd->nd', weights.astype(h.dtype), y_assign)
    return out.reshape(Bn, T, D)


def setup_inputs(seed: int = 0) -> dict:
    key = jax.random.key(seed)
    ks = jax.random.split(key, 24)

    def nrm(k, shape, scale):
        return jax.random.normal(k, shape, jnp.float32) * scale

    return {
        'x': nrm(ks[0], (BATCH, SEQ, D_MODEL), 1.0),
        'c': nrm(ks[1], (BATCH, D_MODEL), 1.0),
        'w_ada': nrm(ks[2], (DEPTH, D_MODEL, 6 * D_MODEL), 0.5 * D_MODEL ** -0.5),
        'b_ada': nrm(ks[3], (DEPTH, 6 * D_MODEL), 0.02),
        'g_norm1': 1.0 + nrm(ks[4], (DEPTH, D_MODEL), 0.02),
        'g_norm2': 1.0 + nrm(ks[5], (DEPTH, D_MODEL), 0.02),
        'w_in': nrm(ks[6], (DEPTH, D_MODEL, P_IN), D_MODEL ** -0.5),
        'w_out': nrm(ks[7], (DEPTH, D_MIX, D_MODEL), D_MIX ** -0.5),
        'gmlp_ln_g': 1.0 + nrm(ks[8], (DEPTH, A_DIM), 0.02),
        'gmlp_ln_b': nrm(ks[9], (DEPTH, A_DIM), 0.02),
        'gmlp_ws': nrm(ks[10], (DEPTH, A_HEADS, GMLP_BLOCK, GMLP_BLOCK), GMLP_BLOCK ** -0.5),
        'gmlp_bs': 1.0 + nrm(ks[11], (DEPTH, A_HEADS, GMLP_BLOCK), 0.02),
        'gla_w_gate': nrm(ks[12], (DEPTH, GLA_RANK, B_KDIM), GLA_RANK ** -0.5),
        'gla_b_gate': nrm(ks[13], (DEPTH, B_KDIM), 0.1),
        'gla_norm_g': 1.0 + nrm(ks[14], (DEPTH, B_VDIM), 0.02),
        'conv_w': nrm(ks[15], (DEPTH, CONV_WIDTH, C_DIM), CONV_WIDTH ** -0.5),
        'conv_b': nrm(ks[16], (DEPTH, C_DIM), 0.02),
        'router_w': nrm(ks[17], (D_MODEL, N_EXPERTS), D_MODEL ** -0.5),
        'router_b': nrm(ks[18], (N_EXPERTS,), 0.01),
        'exp_w1': nrm(ks[19], (DEPTH, N_EXPERTS, D_MODEL, D_FF_EXPERT), D_MODEL ** -0.5),
        'exp_w3': nrm(ks[20], (DEPTH, N_EXPERTS, D_MODEL, D_FF_EXPERT), D_MODEL ** -0.5),
        'exp_w2': nrm(ks[21], (DEPTH, N_EXPERTS, D_FF_EXPERT, D_MODEL), D_FF_EXPERT ** -0.5),
        'g_final': 1.0 + nrm(ks[22], (D_MODEL,), 0.02),
    }


def reference(x, c, w_ada, b_ada, g_norm1, g_norm2, w_in, w_out, gmlp_ln_g, gmlp_ln_b,
              gmlp_ws, gmlp_bs, gla_w_gate, gla_b_gate, gla_norm_g, conv_w, conv_b,
              router_w, router_b, exp_w1, exp_w3, exp_w2, g_final):
    for l in range(DEPTH):
        mod = jax.nn.silu(c) @ w_ada[l] + b_ada[l]
        sh1, sc1, gt1, sh2, sc2, gt2 = jnp.split(mod[:, None, :], 6, axis=-1)
        h = rmsnorm(x, g_norm1[l]) * (1.0 + sc1) + sh1
        x = x + gt1 * hybrid_mixer(h, w_in[l], w_out[l], gmlp_ln_g[l], gmlp_ln_b[l], gmlp_ws[l],
                                   gmlp_bs[l], gla_w_gate[l], gla_b_gate[l], gla_norm_g[l],
                                   conv_w[l], conv_b[l])
        h = rmsnorm(x, g_norm2[l]) * (1.0 + sc2) + sh2
        x = x + gt2 * moe(h, router_w, router_b, exp_w1[l], exp_w3[l], exp_w2[l])
    return rmsnorm(x, g_final)
```

```cpp
#include <hip/hip_runtime.h>
#include <cstdio>
#include <cstdint>
namespace pg8 {
#define PG8_LAS __attribute__((address_space(3)))
typedef unsigned short bf16_t;
typedef short bf16x8 __attribute__((ext_vector_type(8)));
typedef float f32x4 __attribute__((ext_vector_type(4)));
typedef unsigned u32x4 __attribute__((ext_vector_type(4)));
typedef int pg8_v4i __attribute__((ext_vector_type(4)));
typedef int pg8_v8i __attribute__((ext_vector_type(8)));
constexpr int BM = 256, BK = 64, HALF = 128, HTB = HALF * BK * 2  , STAGE_BYTES = 8 * HTB, NXCD = 8, WGM = 8;

__host__ __device__ __forceinline__ int lds_byte(int r, int c) { const int st = (r >> 4) * 2 + (c >> 5), rr = r & 15, cc = c & 31, ob = rr * 64 + cc * 2; return st * 1024 + (ob ^ (((ob >> 9) & 1) << 5)); }
__host__ __device__ __forceinline__ void stage_rc(int b, int& R, int& C) { const int st = b / 1024, sb = b % 1024, swz = sb ^ (((sb >> 9) & 1) << 5); R = (st >> 1) * 16 + swz / 64; C = (st & 1) * 32 + (swz % 64) / 2; }
__host__ __device__ __forceinline__ int perm32(int rho) { const int n = rho >> 4, i = rho & 15; return 8 * (i >> 2) + 4 * n + (i & 3); }

struct Unit { int pm, pn, bo, ui; };
struct Gemm { const bf16_t* A; const bf16_t* Bt; int M, N, K; };

struct StaticOrder {
    static constexpr bool GATHER = false;
    __device__ __forceinline__ unsigned arow(int, int, int) const { return 0u; }
    int nM, nN, nwg, G, c, rot = 0;
    __host__ __device__ void init(int M, int N, int G_, int c_) { nM = M / BM; nN = N / BM; nwg = nM * nN; G = G_; c = c_; }
    __host__ __device__ bool next(int i, Unit& u) const {
        const long L = (long)i * G + c; if (L >= nwg) return false;
        int wgid = (int)L; { const int q = nwg / NXCD, r = nwg % NXCD, xcd = wgid % NXCD, off = wgid / NXCD; wgid = (xcd < r ? xcd * (q + 1) : r * (q + 1) + (xcd - r) * q) + off; }
        const int nig = WGM * nN, gid = wgid / nig, fm = gid * WGM, gsz = (nM - fm) < WGM ? (nM - fm) : WGM;
        u.pm = fm + ((wgid % nig) % gsz); u.pn = (wgid % nig) / gsz; if (rot && (gid & 1)) { u.pn += rot; if (u.pn >= nN) u.pn -= nN; } u.bo = 0; u.ui = i; return true;
    }
    __device__ __forceinline__ void a_ready(const Unit&) const {}
    __device__ __forceinline__ void done(const Unit&) const {}
};

__device__ __forceinline__ unsigned cvt_pk_bf16(float lo, float hi) { unsigned r; asm volatile("v_cvt_pk_bf16_f32 %0, %1, %2" : "=v"(r) : "v"(lo), "v"(hi)); return r; }
typedef float f32x2 __attribute__((ext_vector_type(2)));
__device__ __forceinline__ f32x2 gelu_pk(f32x2 v) {
    const f32x2 av = __builtin_elementwise_abs(v), d = av * 0.2316418882f + 1.0f;
    f32x2 t; t.x = __builtin_amdgcn_rcpf(d.x); t.y = __builtin_amdgcn_rcpf(d.y);
    f32x2 q = t * 0.5307027145f + (-0.7265760135f); q = q * t + 0.7107068705f; q = q * t + (-0.142248368f); q = q * t + 0.127414796f; q = q * t;
    const f32x2 s = (v * v) * (-0.72134752044f);
    f32x2 e; e.x = __builtin_amdgcn_exp2f(s.x); e.y = __builtin_amdgcn_exp2f(s.y);
    const f32x2 m = v * (q * e), r = v - m;
    f32x2 o; o.x = v.x < 0.f ? m.x : r.x; o.y = v.y < 0.f ? m.y : r.y; return o;
}

__device__ __forceinline__ float bf_lo(unsigned w) { return __uint_as_float(w << 16); }
__device__ __forceinline__ float bf_hi(unsigned w) { return __uint_as_float(w & 0xffff0000u); }
__device__ __forceinline__ float silu_f(float a) { return a * __builtin_amdgcn_rcpf(1.0f + __expf(-a)); }

struct EpiInProj {
    static constexpr bool PERM = true, AFTER_DRAIN = false;
    static constexpr int NVM = 16;
    static constexpr bool ALWAYS_FULL = false;
    __device__ __forceinline__ bool full(const Unit& u) const { return u.pn != 11; }
    bf16_t* O; int ldc; const float* rs; float ws;
    __device__ __forceinline__ void operator()(const f32x4 (&acc)[2][2][4][2], const Unit& u, int wr, int wc, int fr, int fq) const {
        asm volatile("" : "+v"(fr), "+v"(fq));
        const int row0 = u.pm * BM + wr * 64 + fr, col0 = u.pn * BM + wc * 32 + 8 * fq;
        const bool act = u.pn < 2, last_tile = u.pn == 11;
        float dqv[8];
#pragma unroll
        for (int q = 0; q < 8; ++q) dqv[q] = rs ? rs[row0 + (q >> 2) * HALF + (q & 3) * 16] * ws : 0.f;
#pragma unroll
        for (int ai = 0; ai < 2; ++ai)
#pragma unroll
            for (int m = 0; m < 4; ++m) { bf16_t* rowp = O + (size_t)(row0 + ai * HALF + m * 16) * ldc + col0; const float dq = dqv[ai * 4 + m];
#pragma unroll
                for (int bj = 0; bj < 2; ++bj) { f32x4 v0 = acc[ai][bj][m][0], v1 = acc[ai][bj][m][1];
                    if (rs) { const pg8_v4i i0 = __builtin_bit_cast(pg8_v4i, v0), i1 = __builtin_bit_cast(pg8_v4i, v1);
                        v0 = (f32x4){(float)i0[0], (float)i0[1], (float)i0[2], (float)i0[3]} * dq; v1 = (f32x4){(float)i1[0], (float)i1[1], (float)i1[2], (float)i1[3]} * dq; }
                    if (last_tile && (bj != 0 || wc != 0 || fq >= 2)) continue;
                    if (act) { f32x2 a = gelu_pk((f32x2){v0[0], v0[1]}), b = gelu_pk((f32x2){v0[2], v0[3]}), c = gelu_pk((f32x2){v1[0], v1[1]}), d = gelu_pk((f32x2){v1[2], v1[3]});
                        v0 = (f32x4){a.x, a.y, b.x, b.y}; v1 = (f32x4){c.x, c.y, d.x, d.y}; }
                    u32x4 w; w.x = cvt_pk_bf16(v0[0], v0[1]); w.y = cvt_pk_bf16(v0[2], v0[3]); w.z = cvt_pk_bf16(v1[0], v1[1]); w.w = cvt_pk_bf16(v1[2], v1[3]);
                    *(u32x4*)(rowp + bj * HALF) = w; } }
    }
};

struct EpiResid {
    static constexpr bool PERM = true, AFTER_DRAIN = false;
    static constexpr int NVM = 32;
    static constexpr bool ALWAYS_FULL = true;
    __device__ __forceinline__ bool full(const Unit& u) const { return true; }
    bf16_t* X; const float* gt; bf16_t* Xo;
    __device__ __forceinline__ void operator()(const f32x4 (&acc)[2][2][4][2], const Unit& u, int wr, int wc, int fr, int fq) const {
        asm volatile("" : "+v"(fr), "+v"(fq));
        const int row0 = u.pm * BM + wr * 64 + fr, col0 = u.pn * BM + wc * 32 + 8 * fq;
        const float* gp = gt + (size_t)(u.pm >> 3) * 6144 + col0;
#pragma unroll
        for (int bj = 0; bj < 2; ++bj) { const f32x4 g0 = *(const f32x4*)(gp + bj * HALF), g1 = *(const f32x4*)(gp + bj * HALF + 4);
        u32x4 xq[8];
#pragma unroll
        for (int q = 0; q < 8; ++q) xq[q] = *(const u32x4*)(X + (size_t)(row0 + (q >> 2) * HALF + (q & 3) * 16) * 1024 + col0 + bj * HALF);
        asm volatile("" ::: "memory");
#pragma unroll
        for (int ai = 0; ai < 2; ++ai)
#pragma unroll
            for (int m = 0; m < 4; ++m) { bf16_t* rowp = X + (size_t)(row0 + ai * HALF + m * 16) * 1024 + col0;
                const u32x4 xv = xq[ai * 4 + m];
                const f32x4 a0 = acc[ai][bj][m][0], a1 = acc[ai][bj][m][1];
                u32x4 w;
                w.x = cvt_pk_bf16(bf_lo(xv.x) + g0[0] * a0[0], bf_hi(xv.x) + g0[1] * a0[1]);
                w.y = cvt_pk_bf16(bf_lo(xv.y) + g0[2] * a0[2], bf_hi(xv.y) + g0[3] * a0[3]);
                w.z = cvt_pk_bf16(bf_lo(xv.z) + g1[0] * a1[0], bf_hi(xv.z) + g1[1] * a1[1]);
                w.w = cvt_pk_bf16(bf_lo(xv.w) + g1[2] * a1[2], bf_hi(xv.w) + g1[3] * a1[3]);
                *(u32x4*)(Xo + (rowp - X) + bj * HALF) = w; } }
    }
};

struct EpiSwiGLU {
    static constexpr bool PERM = true, AFTER_DRAIN = false;
    static constexpr int NVM = 8;
    static constexpr bool ALWAYS_FULL = true;
    __device__ __forceinline__ bool full(const Unit& u) const { return true; }
    bf16_t* O;
    __device__ __forceinline__ void operator()(const f32x4 (&acc)[2][2][4][2], const Unit& u, int wr, int wc, int fr, int fq) const {
        asm volatile("" : "+v"(fr), "+v"(fq));
        const int row0 = u.pm * BM + wr * 64 + fr, col0 = u.pn * HALF + wc * 32 + 8 * fq;
#pragma unroll
        for (int ai = 0; ai < 2; ++ai)
#pragma unroll
            for (int m = 0; m < 4; ++m) { bf16_t* rowp = O + (size_t)(row0 + ai * HALF + m * 16) * 512 + col0;
                const f32x4 a0 = acc[ai][0][m][0], a1 = acc[ai][0][m][1], b0 = acc[ai][1][m][0], b1 = acc[ai][1][m][1];
                u32x4 w;
                w.x = cvt_pk_bf16(silu_f(a0[0]) * b0[0], silu_f(a0[1]) * b0[1]); w.y = cvt_pk_bf16(silu_f(a0[2]) * b0[2], silu_f(a0[3]) * b0[3]);
                w.z = cvt_pk_bf16(silu_f(a1[0]) * b1[0], silu_f(a1[1]) * b1[1]); w.w = cvt_pk_bf16(silu_f(a1[2]) * b1[2], silu_f(a1[3]) * b1[3]);
                *(u32x4*)rowp = w; }
    }
};

__device__ __forceinline__ unsigned pk4_fp8(float a, float b, float c, float d) {
    a = __builtin_amdgcn_fmed3f(a, -448.f, 448.f); b = __builtin_amdgcn_fmed3f(b, -448.f, 448.f); c = __builtin_amdgcn_fmed3f(c, -448.f, 448.f); d = __builtin_amdgcn_fmed3f(d, -448.f, 448.f);
    unsigned w = 0u; w = (unsigned)__builtin_amdgcn_cvt_pk_fp8_f32(a, b, (int)w, false); w = (unsigned)__builtin_amdgcn_cvt_pk_fp8_f32(c, d, (int)w, true); return w;
}
struct EpiSwiGLU8 {
    static constexpr bool PERM = true, AFTER_DRAIN = false;
    static constexpr int NVM = 8;
    static constexpr bool ALWAYS_FULL = true;
    __device__ __forceinline__ bool full(const Unit& u) const { return true; }
    unsigned char* O; float SC;
    __device__ __forceinline__ void operator()(const f32x4 (&acc)[2][2][4][2], const Unit& u, int wr, int wc, int fr, int fq) const {
        asm volatile("" : "+v"(fr), "+v"(fq));
        const int row0 = u.pm * BM + wr * 64 + fr, col0 = u.pn * HALF + wc * 32 + 8 * fq;
#pragma unroll
        for (int ai = 0; ai < 2; ++ai)
#pragma unroll
            for (int m = 0; m < 4; ++m) { unsigned char* rowp = O + (size_t)(row0 + ai * HALF + m * 16) * 512 + col0;
                const f32x4 a0 = acc[ai][0][m][0], a1 = acc[ai][0][m][1], b0 = acc[ai][1][m][0] * SC, b1 = acc[ai][1][m][1] * SC;
                typedef unsigned u32x2 __attribute__((ext_vector_type(2)));
                u32x2 w; w.x = pk4_fp8(silu_f(a0[0]) * b0[0], silu_f(a0[1]) * b0[1], silu_f(a0[2]) * b0[2], silu_f(a0[3]) * b0[3]);
                w.y = pk4_fp8(silu_f(a1[0]) * b1[0], silu_f(a1[1]) * b1[1], silu_f(a1[2]) * b1[2], silu_f(a1[3]) * b1[3]);
                *(u32x2*)rowp = w; }
    }
};

struct EpiScatter8 {
    static constexpr bool PERM = true, AFTER_DRAIN = false;
    static constexpr int NVM = 16;
    static constexpr bool ALWAYS_FULL = true;
    __device__ __forceinline__ bool full(const Unit& u) const { return true; }
    unsigned char* O; const PG8_LAS int* rowtab; float SC;
    __device__ __forceinline__ void operator()(const f32x4 (&acc)[2][2][4][2], const Unit& u, int wr, int wc, int fr, int fq) const {
        asm volatile("" : "+v"(fr), "+v"(fq));
        const int col0 = u.pn * BM + wc * 32 + 8 * fq;
        typedef unsigned u32x2 __attribute__((ext_vector_type(2)));
#pragma unroll
        for (int ai = 0; ai < 2; ++ai)
#pragma unroll
            for (int m = 0; m < 4; ++m) { const int d = rowtab[u.ui * BM + wr * 64 + fr + ai * HALF + m * 16]; unsigned char* rowp = O + (size_t)d * 1024 + col0;
#pragma unroll
                for (int bj = 0; bj < 2; ++bj) { const f32x4 v0 = acc[ai][bj][m][0] * SC, v1 = acc[ai][bj][m][1] * SC;
                    *(u32x2*)(rowp + bj * HALF) = (u32x2){pk4_fp8(v0[0], v0[1], v0[2], v0[3]), pk4_fp8(v1[0], v1[1], v1[2], v1[3])}; } }
    }
};

struct EpiScatter {
    static constexpr bool PERM = true, AFTER_DRAIN = false;
    static constexpr int NVM = 16;
    static constexpr bool ALWAYS_FULL = true;
    __device__ __forceinline__ bool full(const Unit& u) const { return true; }
    bf16_t* O; const PG8_LAS int* rowtab;
    __device__ __forceinline__ void operator()(const f32x4 (&acc)[2][2][4][2], const Unit& u, int wr, int wc, int fr, int fq) const {
        asm volatile("" : "+v"(fr), "+v"(fq));
        const int row0 = u.pm * BM + wr * 64 + fr, col0 = u.pn * BM + wc * 32 + 8 * fq;
#pragma unroll
        for (int ai = 0; ai < 2; ++ai)
#pragma unroll
            for (int m = 0; m < 4; ++m) { const int d = rowtab[u.ui * BM + wr * 64 + fr + ai * HALF + m * 16]; bf16_t* rowp = O + (size_t)d * 1024 + col0;
#pragma unroll
                for (int bj = 0; bj < 2; ++bj) { const f32x4 v0 = acc[ai][bj][m][0], v1 = acc[ai][bj][m][1];
                    u32x4 w; w.x = cvt_pk_bf16(v0[0], v0[1]); w.y = cvt_pk_bf16(v0[2], v0[3]); w.z = cvt_pk_bf16(v1[0], v1[1]); w.w = cvt_pk_bf16(v1[2], v1[3]);
                    *(u32x4*)(rowp + bj * HALF) = w; } }
    }
};

template <class Epi, class Sched, bool ALIGN_EPI = false, bool SP2 = false, int FP8SA = 0, int FP8SB = 0, bool I8 = false>
__device__ __forceinline__ void gemm_phase(PG8_LAS unsigned char* lds, const Gemm g, const Sched& S, const Epi& E, const int tid) {
    const int wid = __builtin_amdgcn_readfirstlane(tid >> 6), lane = tid & 63, wr = wid >> 2, wc = wid & 3, fr = lane & 15, fq = lane >> 4;
    const int K = g.K, nt = K / BK;
    unsigned voffA[2], voffB[2];
    unsigned ga[2][2], gn[2][2];
#pragma unroll
    for (int i = 0; i < 2; ++i) { int R, C; stage_rc(tid * 16 + i * 8192, R, C); const int Rb = Epi::PERM ? ((R & ~31) + perm32(R & 31)) : R;
        voffA[i] = (unsigned)(R * K + C) * 2u; voffB[i] = (unsigned)(Rb * K + C) * 2u; }
    const size_t kstep = (size_t)(BK * 2);
    const size_t hstep = (size_t)HALF * K * 2;
    const size_t tstep = 2 * hstep;
    const unsigned ldsw = (unsigned)wid * 1024u;
    const int aoff = lds_byte(wr * 64 + fr, fq * 8), boff = lds_byte(wc * 32 + fr, fq * 8);
#define PG8_SA(b, h) (((b) * 2 + (h)) * HTB)
#define PG8_SB(b, h) ((4 + (b) * 2 + (h)) * HTB)
#define PG8_STAGE(bufoff, gbase, voff) do { _Pragma("unroll") for (int _i = 0; _i < 2; ++_i) \
        __builtin_amdgcn_global_load_lds((const unsigned*)((const char*)(gbase) + (voff)[_i]), (PG8_LAS unsigned*)(lds + (bufoff) + ldsw + _i * 8192), 16, 0, 0); } while (0)
#define PG8_STAGE_A(bufoff, ptr, h, nx, kb) do { if constexpr (Sched::GATHER) { _Pragma("unroll") for (int _i = 0; _i < 2; ++_i) { const unsigned _o = ((nx) ? gn[h][_i] : ga[h][_i]) + (unsigned)(kb); \
        __builtin_amdgcn_global_load_lds((const unsigned*)((const char*)g.A + _o), (PG8_LAS unsigned*)(lds + (bufoff) + ldsw + _i * 8192), 16, 0, 0); } } else { PG8_STAGE(bufoff, ptr, voffA); } } while (0)
#define PG8_GOFF(dst, ord) do { if constexpr (Sched::GATHER) { _Pragma("unroll") for (int _i = 0; _i < 2; ++_i) { int _R, _C; stage_rc(tid * 16 + _i * 8192, _R, _C);   \
        _Pragma("unroll") for (int _h = 0; _h < 2; ++_h) dst[_h][_i] = S.arow((ord), 128 * _h + _R, K) + (unsigned)_C * 2u; } } } while (0)
#define PG8_LD8(p) __builtin_shufflevector(*(const PG8_LAS pg8_v4i*)(p), *(const PG8_LAS pg8_v4i*)((p) + 1024), 0, 1, 2, 3, 4, 5, 6, 7)
#define PG8_LDA(dst, b, h) do { if constexpr (FP8SA != 0) { _Pragma("unroll") for (int m = 0; m < 4; ++m) dst##8[m] = PG8_LD8(lds + PG8_SA(b, h) + aoff + m * 2048); } \
        else { _Pragma("unroll") for (int m = 0; m < 4; ++m) _Pragma("unroll") for (int k = 0; k < 2; ++k) dst[m][k] = *(const PG8_LAS bf16x8*)(lds + PG8_SA(b, h) + aoff + m * 2048 + k * 1024); } } while (0)
#define PG8_LDB(dst, b, h) do { if constexpr (FP8SA != 0) { _Pragma("unroll") for (int n = 0; n < 2; ++n) dst##8[n] = PG8_LD8(lds + PG8_SB(b, h) + boff + n * 2048); } \
        else { _Pragma("unroll") for (int n = 0; n < 2; ++n) _Pragma("unroll") for (int k = 0; k < 2; ++k) dst[n][k] = *(const PG8_LAS bf16x8*)(lds + PG8_SB(b, h) + boff + n * 2048 + k * 1024); } } while (0)
#define PG8_MMA(ai, bj, At, Bt) do { __builtin_amdgcn_s_setprio(1); _Pragma("unroll") for (int m = 0; m < 4; ++m) _Pragma("unroll") for (int n = 0; n < 2; ++n) { \
        if constexpr (FP8SA != 0) asm volatile("v_mfma_scale_f32_16x16x128_f8f6f4 %0, %1, %2, %0, %3, %4 op_sel_hi:[0,0,0]" : "+v"(acc[ai][bj][m][n]) : "v"(Bt##8[n]), "v"(At##8[m]), "v"(sc8b), "v"(sc8a));   \
        else if constexpr (I8) { _Pragma("unroll") for (int k = 0; k < 2; ++k) acc[ai][bj][m][n] = __builtin_bit_cast(f32x4, __builtin_amdgcn_mfma_i32_16x16x64_i8(__builtin_bit_cast(pg8_v4i, Bt[n][k]), __builtin_bit_cast(pg8_v4i, At[m][k]), __builtin_bit_cast(pg8_v4i, acc[ai][bj][m][n]), 0, 0, 0)); } \
        else { _Pragma("unroll") for (int k = 0; k < 2; ++k) acc[ai][bj][m][n] = __builtin_amdgcn_mfma_f32_16x16x32_bf16(Bt[n][k], At[m][k], acc[ai][bj][m][n], 0, 0, 0); } } __builtin_amdgcn_s_setprio(0); } while (0)
#define PG8_WAIT_V(n) asm volatile("s_waitcnt vmcnt(" #n ")" ::: "memory")
#define PG8_WAIT_VN(n) asm volatile("s_waitcnt vmcnt(%0)" :: "n"(n) : "memory")
#define PG8_WAIT_VR(rl) do { if (rl) PG8_WAIT_VN(8 + Epi::NVM); else PG8_WAIT_V(8); } while (0)
#define PG8_WAIT_L(n) asm volatile("s_waitcnt lgkmcnt(" #n ")" ::: "memory")
#define PG8_BAR __builtin_amdgcn_s_barrier()
#define PG8_SCHED __builtin_amdgcn_sched_barrier(0)
    Unit cur, nxt; int ui = 0;
    if (!S.next(0, cur)) return;
    f32x4 acc[2][2][4][2];
#pragma unroll
    for (int a = 0; a < 2; ++a)
#pragma unroll
        for (int b = 0; b < 2; ++b)
#pragma unroll
            for (int m = 0; m < 4; ++m)
#pragma unroll
                for (int n = 0; n < 2; ++n) acc[a][b][m][n] = (f32x4){0.f, 0.f, 0.f, 0.f};
    bf16x8 At[4][2], B0[2][2], B1[2][2];
    pg8_v8i At8[4], B08[2], B18[2];
    const int sc8a = FP8SA * 0x01010101, sc8b = FP8SB * 0x01010101;
    const char* cA = (const char*)g.A + (size_t)cur.pm * tstep; const char* cB = (const char*)g.Bt + (size_t)cur.bo * 2 + (size_t)cur.pn * tstep;
    S.a_ready(cur);
    PG8_GOFF(ga, 0); PG8_GOFF(gn, 0);
    if constexpr (SP2) {
        PG8_STAGE(PG8_SB(0, 0), cB, voffB); PG8_STAGE(PG8_SB(0, 1), cB + hstep, voffB); PG8_STAGE_A(PG8_SA(0, 0), cA, 0, false, 0); PG8_STAGE_A(PG8_SA(0, 1), cA + hstep, 1, false, 0);
        if (wr == 1) PG8_BAR;
        PG8_WAIT_V(2); PG8_BAR;
        PG8_STAGE(PG8_SB(1, 0), cB + kstep, voffB); PG8_STAGE_A(PG8_SA(1, 0), cA + kstep, 0, false, kstep); PG8_STAGE(PG8_SB(1, 1), cB + hstep + kstep, voffB);
        PG8_WAIT_V(6); PG8_BAR;
    } else {
        PG8_STAGE(PG8_SB(0, 0), cB, voffB); PG8_STAGE(PG8_SA(0, 0), cA, voffA); PG8_STAGE(PG8_SB(0, 1), cB + hstep, voffB); PG8_STAGE(PG8_SA(0, 1), cA + hstep, voffA);
        if (wr == 1) PG8_BAR;
        PG8_WAIT_V(4); PG8_BAR;
        PG8_STAGE(PG8_SB(1, 0), cB + kstep, voffB); PG8_STAGE(PG8_SA(1, 0), cA + kstep, voffA); PG8_STAGE(PG8_SB(1, 1), cB + hstep + kstep, voffB);
        PG8_WAIT_V(6); PG8_BAR;
    }
    bool relax = false;
    for (;;) {
        const bool has_next = S.next(ui + 1, nxt);
        if constexpr (Sched::GATHER) { if (has_next) PG8_GOFF(gn, ui + 1); else { _Pragma("unroll") for (int _h = 0; _h < 2; ++_h) _Pragma("unroll") for (int _i = 0; _i < 2; ++_i) gn[_h][_i] = ga[_h][_i]; } }
        const char* nA = has_next ? (const char*)g.A + (size_t)nxt.pm * tstep : cA; const char* nB = has_next ? (const char*)g.Bt + (size_t)nxt.bo * 2 + (size_t)nxt.pn * tstep : cB;
#pragma nounroll
        for (int t = 0; t < nt; t += 2) {
            const bool last = (t == nt - 2);
            const char* a1 = cA + (size_t)(t + 1) * kstep;
            const char* a2 = last ? nA : cA + (size_t)(t + 2) * kstep; const char* b2 = last ? nB : cB + (size_t)(t + 2) * kstep;
            const char* a3 = a2 + kstep; const char* b3 = b2 + kstep;
            const size_t kb1 = (size_t)(t + 1) * kstep, kb2 = last ? 0 : (size_t)(t + 2) * kstep, kb3 = kb2 + kstep;
            if (last && has_next) S.a_ready(nxt);
            if constexpr (SP2) {
            const bool rl = Epi::ALWAYS_FULL ? (ui > 0 && t == 0) : (relax && t == 0);
            PG8_LDB(B0, 0, 0); PG8_LDB(B1, 0, 1); PG8_SCHED; PG8_LDA(At, 0, 0); if (!rl) PG8_STAGE_A(PG8_SA(1, 1), a1 + hstep, 1, false, kb1);
            PG8_WAIT_VR(rl); PG8_WAIT_L(0); PG8_BAR; PG8_MMA(0, 0, At, B0); PG8_MMA(0, 1, At, B1); PG8_BAR; PG8_SCHED;
            PG8_LDA(At, 0, 1); PG8_STAGE(PG8_SB(0, 0), b2, voffB); PG8_STAGE(PG8_SB(0, 1), b2 + hstep, voffB); PG8_STAGE_A(PG8_SA(0, 0), a2, 0, last, kb2);
            PG8_WAIT_VR(rl); PG8_WAIT_L(0); PG8_BAR; PG8_MMA(1, 0, At, B0); PG8_MMA(1, 1, At, B1); PG8_BAR; PG8_SCHED;
            PG8_LDB(B0, 1, 0); PG8_LDB(B1, 1, 1); PG8_SCHED; PG8_LDA(At, 1, 0); PG8_STAGE_A(PG8_SA(0, 1), a2 + hstep, 1, last, kb2);
            PG8_WAIT_VR(rl); PG8_WAIT_L(0); PG8_BAR; PG8_MMA(0, 0, At, B0); PG8_MMA(0, 1, At, B1); PG8_BAR; PG8_SCHED;
            PG8_LDA(At, 1, 1); PG8_STAGE(PG8_SB(1, 0), b3, voffB); PG8_STAGE(PG8_SB(1, 1), b3 + hstep, voffB); PG8_STAGE_A(PG8_SA(1, 0), a3, 0, last, kb3);
            PG8_WAIT_V(8); PG8_WAIT_L(0); PG8_BAR; PG8_MMA(1, 0, At, B0); PG8_MMA(1, 1, At, B1); PG8_BAR; PG8_SCHED;
            } else {
            PG8_LDB(B0, 0, 0); PG8_SCHED; PG8_LDA(At, 0, 0); PG8_STAGE(PG8_SA(1, 1), a1 + hstep, voffA);
            PG8_WAIT_L(8); PG8_BAR; PG8_WAIT_L(0); PG8_MMA(0, 0, At, B0); PG8_BAR; PG8_SCHED;
            PG8_LDB(B1, 0, 1); PG8_STAGE(PG8_SB(0, 0), b2, voffB);
            PG8_BAR; PG8_WAIT_L(0); PG8_MMA(0, 1, At, B1); PG8_BAR;
            PG8_LDA(At, 0, 1); PG8_STAGE(PG8_SA(0, 0), a2, voffA);
            PG8_BAR; PG8_WAIT_L(0); PG8_MMA(1, 0, At, B0); PG8_BAR; PG8_SCHED;
            PG8_STAGE(PG8_SB(0, 1), b2 + hstep, voffB);
            PG8_WAIT_V(6); PG8_BAR; PG8_MMA(1, 1, At, B1); PG8_BAR;
            PG8_LDB(B0, 1, 0); PG8_SCHED; PG8_LDA(At, 1, 0); PG8_STAGE(PG8_SA(0, 1), a2 + hstep, voffA);
            PG8_WAIT_L(8); PG8_BAR; PG8_WAIT_L(0); PG8_MMA(0, 0, At, B0); PG8_BAR; PG8_SCHED;
            PG8_LDB(B1, 1, 1); PG8_STAGE(PG8_SB(1, 0), b3, voffB);
            PG8_BAR; PG8_WAIT_L(0); PG8_MMA(0, 1, At, B1); PG8_BAR;
            PG8_LDA(At, 1, 1); PG8_STAGE(PG8_SA(1, 0), a3, voffA);
            PG8_BAR; PG8_WAIT_L(0); PG8_MMA(1, 0, At, B0); PG8_BAR; PG8_SCHED;
            PG8_STAGE(PG8_SB(1, 1), b3 + hstep, voffB);
            PG8_WAIT_V(6); PG8_BAR; PG8_MMA(1, 1, At, B1); PG8_BAR;
            }
        }
        if constexpr (ALIGN_EPI) { if (wr == 0) PG8_BAR; }
        if constexpr (ALIGN_EPI && SP2) {
            relax = has_next && (Epi::ALWAYS_FULL || E.full(cur));
            if (relax) PG8_STAGE_A(PG8_SA(1, 1), nA + kstep + hstep, 1, true, kstep);
            asm volatile("" ::: "memory");
        }
        if constexpr (FP8SA != 0) asm volatile("s_nop 15\n\ts_nop 15" ::: "memory");
        if constexpr (!Epi::AFTER_DRAIN) { E(acc, cur, wr, wc, fr, fq); S.done(cur); }
        if (!has_next) break;
#pragma unroll
        for (int a = 0; a < 2; ++a)
#pragma unroll
            for (int b = 0; b < 2; ++b)
#pragma unroll
                for (int m = 0; m < 4; ++m)
#pragma unroll
                    for (int n = 0; n < 2; ++n) acc[a][b][m][n] = (f32x4){0.f, 0.f, 0.f, 0.f};
        cur = nxt; cA = nA; cB = nB; ++ui;
        if constexpr (Sched::GATHER) { _Pragma("unroll") for (int _h = 0; _h < 2; ++_h) _Pragma("unroll") for (int _i = 0; _i < 2; ++_i) ga[_h][_i] = gn[_h][_i]; }
        if constexpr (ALIGN_EPI) { if (wr == 1) PG8_BAR; }
    }
    PG8_WAIT_V(0);
    if constexpr (!ALIGN_EPI) { if (wr == 0) PG8_BAR; }
    PG8_BAR;
    if constexpr (Epi::AFTER_DRAIN) { E.fused(acc, cur, wr, wc, fr, fq, lds, wid, lane); S.done(cur); }
#undef PG8_SA
#undef PG8_SB
#undef PG8_STAGE
#undef PG8_STAGE_A
#undef PG8_GOFF
#undef PG8_LDA
#undef PG8_LDB
#undef PG8_MMA
#undef PG8_LD8
#undef PG8_WAIT_V
#undef PG8_WAIT_L
#undef PG8_BAR
#undef PG8_SCHED
}
}
#ifndef MK_N_LAUNCHES
#define MK_N_LAUNCHES 1
#endif
constexpr int NPHASES = 20;

constexpr int NTOK = 32768, DM = 1024, SEQ = 2048, NBATCH = 16, NLAYER = 2;
constexpr int PIN = 2832, PNP = 3072;
constexpr int PC_U = 0, PC_VV = 256, PC_Q = 512, PC_K = 768, PC_V = 1024, PC_OG = 1536, PC_CB = 2048, PC_CC = 2304, PC_CX = 2560, PC_G = 2816;
constexpr int NEXP = 32, DFF = 512;
constexpr int MAXSLOT = 73728;
constexpr int DUMMY_ROW = 65536;
constexpr float EPS = 1e-6f;

constexpr size_t MiB = 1u << 20;
constexpr size_t WS_CTL = 0, CTL_ZERO_BYTES = 131072;
constexpr size_t WS_WIN = 2 * MiB;
constexpr size_t WS_WOUT = 14 * MiB;
constexpr size_t WS_W13 = 18 * MiB;
constexpr size_t WS_W2 = 146 * MiB;
constexpr size_t WS_GW = 210 * MiB;
constexpr size_t WS_WR = 210 * MiB + 524288;
constexpr size_t WS_WG = 210 * MiB + 655360;
constexpr size_t WS_ROUTE = 211 * MiB;
constexpr size_t WS_X = 214 * MiB;
constexpr size_t WS_HY = 278 * MiB;
constexpr size_t WS_P = 342 * MiB;
constexpr size_t WS_H2 = 278 * MiB;
constexpr size_t WS_HID = 422 * MiB;
constexpr size_t WS_YE = 278 * MiB;
constexpr size_t WS_LIST = 534 * MiB;
constexpr size_t WS_END = 538 * MiB;
static_assert(WS_HID + (size_t)MAXSLOT * 512 * 2 <= WS_LIST && WS_YE + (size_t)65537 * 2048 <= WS_HID, "ws map");
constexpr size_t RT_E = 0;
constexpr size_t RT_POS = 131072;
constexpr size_t RT_W = 393216;
constexpr size_t RT_RSTD = 655360;
constexpr size_t RT_DST = 786432;
constexpr size_t RT_DEC = 1081344;
static_assert(RT_DEC + 2048 * 64 * 4 <= 3 * MiB, "route region");
constexpr int CW_BAR = 4096;
constexpr int CW_CNT = 16384;
constexpr size_t CTL_MOD = 131072;
static_assert(CTL_MOD >= CTL_ZERO_BYTES && CTL_MOD + 2 * 16 * 6144 * 4 <= 2 * MiB && (CW_CNT + 4 * 64 + 32) * 4 <= (int)CTL_ZERO_BYTES, "ctl");

constexpr int RING_BYTES = 131072;
constexpr int LTAB_OFF = 133120;
constexpr int LDSCTL_OFF = 162816;
constexpr int LDS_BYTES = 163840;
constexpr int NWAVES = 8;

#define GAS __attribute__((address_space(1)))
#define LAS __attribute__((address_space(3)))
typedef unsigned short bf16;
typedef unsigned v4u __attribute__((ext_vector_type(4)));
typedef unsigned v2u __attribute__((ext_vector_type(2)));
typedef float f32x4 __attribute__((ext_vector_type(4)));
typedef short bf16x8 __attribute__((ext_vector_type(8)));
typedef GAS unsigned gu32;
#define RLX_AGENT __ATOMIC_RELAXED, __HIP_MEMORY_SCOPE_AGENT
#define LDS_WAIT() asm volatile("s_waitcnt lgkmcnt(0)" ::: "memory")
__device__ __forceinline__ unsigned f2bf(float f) { unsigned u = __builtin_bit_cast(unsigned, f); return (u + 0x7fffu + ((u >> 16) & 1u)) >> 16; }
__device__ __forceinline__ unsigned pk2(float lo, float hi) { unsigned r; asm("v_cvt_pk_bf16_f32 %0, %1, %2" : "=v"(r) : "v"(lo), "v"(hi)); return r; }
#ifndef FP8_MASK
#define FP8_MASK 0xFE
#endif
#define FP8_ON(l, g) (((FP8_MASK) >> (4 * (l) + (g))) & 1)
#ifndef I8_MASK
#define I8_MASK 0x3
#endif
#define I8_ON(l) (((I8_MASK) >> (l)) & 1)
constexpr float WI8S = 127.0f * 32.0f / 5.5f;
#ifndef YE_FP8
#define YE_FP8 0
#endif
constexpr float W8S = 32.0f, H8S = 32.0f, Y8S = 4.0f, E8S = 8.0f;
constexpr int E8_ONE = 127, E8_W = 122, E8_H = 122, E8_Y = 125;
__device__ __forceinline__ unsigned pk4f8(float a, float b, float c, float d) {
    a = __builtin_amdgcn_fmed3f(a, -448.f, 448.f); b = __builtin_amdgcn_fmed3f(b, -448.f, 448.f); c = __builtin_amdgcn_fmed3f(c, -448.f, 448.f); d = __builtin_amdgcn_fmed3f(d, -448.f, 448.f);
    unsigned w = 0u; w = (unsigned)__builtin_amdgcn_cvt_pk_fp8_f32(a, b, (int)w, false); w = (unsigned)__builtin_amdgcn_cvt_pk_fp8_f32(c, d, (int)w, true); return w;
}
__device__ __forceinline__ unsigned pk4i8(float a, float b, float c, float d) {
    const int i0 = (int)__builtin_rintf(__builtin_amdgcn_fmed3f(a, -127.f, 127.f)), i1 = (int)__builtin_rintf(__builtin_amdgcn_fmed3f(b, -127.f, 127.f)),
              i2 = (int)__builtin_rintf(__builtin_amdgcn_fmed3f(c, -127.f, 127.f)), i3 = (int)__builtin_rintf(__builtin_amdgcn_fmed3f(d, -127.f, 127.f));
    return (unsigned)(i0 & 255) | ((unsigned)(i1 & 255) << 8) | ((unsigned)(i2 & 255) << 16) | ((unsigned)i3 << 24);
}
__device__ __forceinline__ float fexp(float x) { return __builtin_amdgcn_exp2f(x * 1.44269504f); }
__device__ __forceinline__ float flog(float x) { return __builtin_amdgcn_logf(x) * 0.69314718f; }
__device__ __forceinline__ float bf2f(unsigned short h) { return __uint_as_float((unsigned)h << 16); }
__device__ __forceinline__ float bflo(unsigned w) { return __uint_as_float(w << 16); }
__device__ __forceinline__ float bfhi(unsigned w) { return __uint_as_float(w & 0xffff0000u); }
#define DPP_F(x, ctrl) __int_as_float(__builtin_amdgcn_update_dpp(0, __float_as_int(x), (ctrl), 0xf, 0xf, true))
__device__ __forceinline__ float row_sum16(float v) {
    v += DPP_F(v, 0xB1); v += DPP_F(v, 0x4E); v += DPP_F(v, 0x141); v += DPP_F(v, 0x140);
    return v;
}
__device__ __forceinline__ float row_prefix16(float v) {
    v += DPP_F(v, 0x111); v += DPP_F(v, 0x112); v += DPP_F(v, 0x114); v += DPP_F(v, 0x118);
    return v;
}
__device__ __forceinline__ float wave_max_nonneg(float v) {
    v = fmaxf(v, DPP_F(v, 0xB1)); v = fmaxf(v, DPP_F(v, 0x4E)); v = fmaxf(v, DPP_F(v, 0x141)); v = fmaxf(v, DPP_F(v, 0x140));
    const int i = __float_as_int(v);
    return fmaxf(fmaxf(__int_as_float(__builtin_amdgcn_readlane(i, 0)), __int_as_float(__builtin_amdgcn_readlane(i, 16))), fmaxf(__int_as_float(__builtin_amdgcn_readlane(i, 32)), __int_as_float(__builtin_amdgcn_readlane(i, 48))));
}
__device__ __forceinline__ float wave_sum(float v) {
    v = row_sum16(v);
    const int i = __float_as_int(v);
    return (__int_as_float(__builtin_amdgcn_readlane(i, 0)) + __int_as_float(__builtin_amdgcn_readlane(i, 16))) + (__int_as_float(__builtin_amdgcn_readlane(i, 32)) + __int_as_float(__builtin_amdgcn_readlane(i, 48)));
}

#define XB_TMO      128
#define XB_XCNT(j)  (256  + 64 * (j))
#define XB_XSUB(j)  (1280 + 64 * (j))
#define XB_XGEN(j)  (2304 + 64 * (j))
#define XB_TOP      3328
#define XB_TOPGEN   3392
#define XCD_BAR_WORDS 3456
#define XB_SPIN_CAP (1u << 21)
__device__ __forceinline__ unsigned xb_ld(unsigned* p)              { return __hip_atomic_load(p, __ATOMIC_RELAXED, __HIP_MEMORY_SCOPE_AGENT); }
__device__ __forceinline__ unsigned xb_add(unsigned* p, unsigned v) { return __hip_atomic_fetch_add(p, v, __ATOMIC_RELAXED, __HIP_MEMORY_SCOPE_AGENT); }
__device__ __forceinline__ unsigned xb_xcc_id() { return (unsigned)__builtin_amdgcn_s_getreg((3 << 11) | 20) & 0xFu; }
#define XB_SPIN(cond, bar) do { unsigned _sp = 0; while (cond) { __builtin_amdgcn_s_sleep(1); \
    if ((++_sp & 255u) == 0u) { if (xb_ld(&(bar)[XB_TMO])) break; if (_sp > XB_SPIN_CAP) { atomicAdd(&(bar)[XB_TMO], 1u); break; } } } } while (0)
struct XcdBarrier { unsigned* bar; unsigned x; volatile LAS unsigned* st; };
__device__ __forceinline__ XcdBarrier xcd_barrier_post(unsigned* bar, volatile LAS unsigned* st) {
    XcdBarrier b; b.bar = bar; b.x = xb_xcc_id(); b.st = st;
    if (threadIdx.x == 0) (void)xb_add(&bar[XB_XCNT(b.x)], 1u);
    return b;
}
__device__ __forceinline__ void xcd_barrier_complete(unsigned* bar, unsigned x, unsigned& nloc, unsigned& nx) {
    const unsigned G = gridDim.x * gridDim.y * gridDim.z;
    unsigned sum, cnt, mine, sp = 0u;
    for (;;) {
        sum = 0u; cnt = 0u; mine = 0u;
#pragma unroll
        for (unsigned j = 0; j < 16; ++j) { const unsigned c = xb_ld(&bar[XB_XCNT(j)]); sum += c; cnt += (c > 0u) ? 1u : 0u; mine = (j == x) ? c : mine; }
        if (sum == G) break;
        __builtin_amdgcn_s_sleep(1);
        if ((++sp & 255u) == 0u) { if (xb_ld(&bar[XB_TMO])) break; if (sp > XB_SPIN_CAP) { atomicAdd(&bar[XB_TMO], 1u); break; } }
    }
    nloc = mine > 0u ? mine : 1u; nx = cnt > 0u ? cnt : 1u;
}
__device__ __forceinline__ void xcd_barrier(const XcdBarrier& b, bool leader) {
    asm volatile("s_waitcnt vmcnt(0)" ::: "memory");
    __syncthreads();
    if (leader) {
        unsigned* bar = b.bar;
        __builtin_amdgcn_s_waitcnt(0);
        unsigned nloc = b.st[0], nx = b.st[1];
        if (nloc == 0u) { xcd_barrier_complete(bar, b.x, nloc, nx); b.st[0] = nloc; b.st[1] = nx; }
        const unsigned old = xb_add(&bar[XB_XSUB(b.x)], 1u);
        const unsigned gen = old / nloc;
        if (old + 1u == (gen + 1u) * nloc) {
            __builtin_amdgcn_fence(__ATOMIC_RELEASE, "agent");
            asm volatile("s_waitcnt vmcnt(0)" ::: "memory");
            const unsigned og = xb_add(&bar[XB_TOP], 1u);
            const unsigned tg = og / nx;
            if (og + 1u == (tg + 1u) * nx) xb_add(&bar[XB_TOPGEN], 1u);
            else XB_SPIN(xb_ld(&bar[XB_TOPGEN]) == tg, bar);
            __builtin_amdgcn_fence(__ATOMIC_ACQUIRE, "agent");
            xb_add(&bar[XB_XGEN(b.x)], 1u);
            asm volatile("s_waitcnt vmcnt(0)" ::: "memory");
        } else {
            XB_SPIN(xb_ld(&bar[XB_XGEN(b.x)]) == gen, bar);
            __builtin_amdgcn_fence(__ATOMIC_ACQUIRE, "agent");
            asm volatile("s_waitcnt vmcnt(0)" ::: "memory");
        }
    }
    __syncthreads();
}

typedef const float* fptr_t;
typedef const __attribute__((address_space(4))) fptr_t* KArgPtr;
struct Frame {
    LAS unsigned char* lds;
    int tid, lane, wave, vcu, G;
    KArgPtr inp;
    float* out; unsigned char* ws;
};
enum { I_X = 0, I_C, I_WADA, I_BADA, I_GN1, I_GN2, I_WIN, I_WOUT, I_LNG, I_LNB, I_GWS, I_GBS, I_WGATE, I_BGATE, I_GLAG, I_CONVW, I_CONVB, I_RW, I_RB, I_W1, I_W3, I_W2, I_GF };
__device__ __forceinline__ bf16* wsb(const Frame& F, size_t off) { return (bf16*)(F.ws + off); }
__device__ __forceinline__ float* hsp(const Frame& F) { return (float*)(F.ws + WS_ROUTE + RT_RSTD); }
__device__ __forceinline__ bf16* h8p(const Frame& F) { return (bf16*)((unsigned char*)F.out + 96 * MiB); }
__device__ __forceinline__ const float* modp(const Frame& F, int l) { return (const float*)(F.ws + WS_CTL + CTL_MOD) + (size_t)l * 16 * 6144; }

struct TrItem { const float* W; bf16* WT; int ldw, n0, nv, k0, ldk, d0, fp8; };
constexpr int TR_IN = 16 * 45, TR_OUT = 16 * 16, TR_E = 2 * 128 + 128, TR_L = TR_IN + TR_OUT + 32 * TR_E;
__device__ __forceinline__ TrItem tr_decode(const Frame& F, int it) {
    TrItem t; const int l = it / TR_L; int r = it % TR_L; t.nv = 64; t.fp8 = 0;
    if (r < TR_IN) { const int kb = r / 45, nb = r % 45;
        if (nb < 24) { t.n0 = 64 * nb; t.d0 = t.n0; } else if (nb < 44) { t.n0 = 1552 + 64 * (nb - 24); t.d0 = 1536 + 64 * (nb - 24); } else { t.n0 = 1536; t.d0 = 2816; t.nv = 16; }
        t.W = F.inp[I_WIN] + (size_t)l * DM * PIN; t.ldw = PIN; t.k0 = 64 * kb; t.WT = wsb(F, WS_WIN) + (size_t)l * PNP * DM; t.ldk = DM; t.fp8 = I8_ON(l) ? 2 : FP8_ON(l, 0); return t; }
    r -= TR_IN;
    if (r < TR_OUT) { const int kb = r / 16, nb = r % 16;
        t.W = F.inp[I_WOUT] + (size_t)l * DM * DM; t.ldw = DM; t.n0 = 64 * nb; t.k0 = 64 * kb; t.WT = wsb(F, WS_WOUT) + (size_t)l * DM * DM; t.ldk = DM; t.d0 = 64 * nb; t.fp8 = FP8_ON(l, 1); return t; }
    r -= TR_OUT;
    const int e = r / TR_E; r %= TR_E; const size_t le = (size_t)l * NEXP + e;
    if (r < 256) { const int s = r >> 7, rr = r & 127, kb = rr / 8, nb = rr % 8;
        t.W = F.inp[s ? I_W3 : I_W1] + le * DM * DFF; t.ldw = DFF; t.n0 = 64 * nb; t.k0 = 64 * kb; t.WT = wsb(F, WS_W13) + le * DM * DM; t.ldk = DM; t.d0 = 256 * (t.n0 >> 7) + 128 * s + (t.n0 & 127); t.fp8 = FP8_ON(l, 2); return t; }
    r -= 256;
    { const int kb = r / 16, nb = r % 16; t.fp8 = FP8_ON(l, 3);
        t.W = F.inp[I_W2] + le * DFF * DM; t.ldw = DM; t.n0 = 64 * nb; t.k0 = 64 * kb; t.WT = wsb(F, WS_W2) + le * DM * DFF; t.ldk = DFF; t.d0 = 64 * nb; return t; }
}
__device__ __forceinline__ void tr_load(const TrItem& t, float (&r)[64], int lane) {
    const int kq = lane >> 4, nq = (lane & 15) * 4;
    const float* p = t.W + (size_t)(t.k0 + kq) * t.ldw + t.n0 + nq; const bool ok = nq < t.nv;
#pragma unroll
    for (int i = 0; i < 16; ++i) { const f32x4 v = ok ? __builtin_nontemporal_load((const f32x4*)(p + (size_t)(4 * i) * t.ldw)) : (f32x4){0.f, 0.f, 0.f, 0.f};
        r[4 * i] = v[0]; r[4 * i + 1] = v[1]; r[4 * i + 2] = v[2]; r[4 * i + 3] = v[3]; }
}
__device__ __forceinline__ void tr_store(const TrItem& t, const float (&r)[64], LAS float* scr, int lane, int var) {
    { const int kq = lane >> 4, nq = (lane & 15) * 4;
#pragma unroll
      for (int i = 0; i < 64; ++i) scr[(4 * (i >> 2) + kq) * 65 + nq + (i & 3)] = r[i]; }
    LDS_WAIT(); asm volatile("" ::: "memory");
    const int ck = lane & 7;
#pragma unroll
    for (int j = 0; j < 8; ++j) { const int n = (lane >> 3) + 8 * j; const LAS float* s = scr + (8 * ck) * 65 + n;
        if (var == 1) continue;
        if (t.fp8 == 2) { if (n < t.nv) *(v2u*)((unsigned char*)t.WT + (size_t)(t.d0 + n) * t.ldk + t.k0 + 8 * ck) = (v2u){pk4i8(s[0 * 65] * WI8S, s[1 * 65] * WI8S, s[2 * 65] * WI8S, s[3 * 65] * WI8S), pk4i8(s[4 * 65] * WI8S, s[5 * 65] * WI8S, s[6 * 65] * WI8S, s[7 * 65] * WI8S)}; }
        else if (t.fp8) { if (n < t.nv) *(v2u*)((unsigned char*)t.WT + (size_t)(t.d0 + n) * t.ldk + t.k0 + 8 * ck) = (v2u){pk4f8(s[0 * 65] * W8S, s[1 * 65] * W8S, s[2 * 65] * W8S, s[3 * 65] * W8S), pk4f8(s[4 * 65] * W8S, s[5 * 65] * W8S, s[6 * 65] * W8S, s[7 * 65] * W8S)}; }
        else { v4u o; o.x = pk2(s[0 * 65], s[1 * 65]); o.y = pk2(s[2 * 65], s[3 * 65]); o.z = pk2(s[4 * 65], s[5 * 65]); o.w = pk2(s[6 * 65], s[7 * 65]);
            if (n < t.nv) *(v4u*)(t.WT + (size_t)(t.d0 + n) * t.ldk + t.k0 + 8 * ck) = o; } }
    LDS_WAIT(); asm volatile("" ::: "memory");
}
__device__ __forceinline__ void p0_prologue(Frame& F, int var) {
    LAS float* scr = (LAS float*)(F.lds + F.wave * 16640);
    const int gw = F.vcu * NWAVES + F.wave, NGW = F.G * NWAVES;
    constexpr int NITEMS = 2 * TR_L;
    for (int it = gw; it < NITEMS; it += NGW) {
        const TrItem ta = tr_decode(F, NITEMS - 1 - it);
        float ra[64];
        tr_load(ta, ra, F.lane);
        if (var == 2) { float sacc = 0.f; _Pragma("unroll") for (int i = 0; i < 64; ++i) sacc += ra[i]; if (sacc == 1.2345e30f) scr[F.lane] = sacc; }
        else tr_store(ta, ra, scr, F.lane, var);
    }
    { const int idx = F.vcu * 512 + F.tid;
      if (idx < 2 * 4 * 128 * 128) { const int s = idx & 127, t = (idx >> 7) & 127; const float w = F.inp[I_GWS][idx];
          wsb(F, WS_GW)[idx] = (bf16)f2bf(((t >> 6) >= (s >> 6)) ? w : 0.f); } }
    { const int idx = F.vcu * 512 + F.tid; if (idx < 32 * 1024) wsb(F, WS_WR)[idx] = (bf16)f2bf(F.inp[I_RW][(idx & 1023) * 32 + (idx >> 10)]); }
    { const int idx = F.vcu * 512 + F.tid; if (idx < 2 * 256 * 16) wsb(F, WS_WG)[idx] = (bf16)f2bf(F.inp[I_WGATE][((idx >> 12) * 16 + (idx & 15)) * 256 + ((idx >> 4) & 255)]); }
    __syncthreads();
    {
        const int l = F.vcu >> 7, cbase = (F.vcu & 127) * 48, kg = F.tid >> 4, cl = F.tid & 15;
        LAS float* sc = (LAS float*)F.lds;
        for (int i = F.tid; i < 16 * 1024; i += 512) { const float v = F.inp[I_C][i]; sc[i] = v / (1.0f + __expf(-v)); }
        __syncthreads();
        float acc[3][16];
#pragma unroll
        for (int q = 0; q < 3; ++q)
#pragma unroll
            for (int b = 0; b < 16; ++b) acc[q][b] = 0.f;
        const float* wp = F.inp[I_WADA] + (size_t)l * DM * 6144 + cbase + cl;
#pragma unroll 2
        for (int i = 0; i < 32; ++i) { const int k = kg + 32 * i; const float w0 = wp[(size_t)k * 6144], w1 = wp[(size_t)k * 6144 + 16], w2 = wp[(size_t)k * 6144 + 32];
#pragma unroll
            for (int b = 0; b < 16; ++b) { const float s = sc[b * 1024 + k]; acc[0][b] += s * w0; acc[1][b] += s * w1; acc[2][b] += s * w2; } }
        __syncthreads();
        LAS float* part = (LAS float*)F.lds;
#pragma unroll
        for (int q = 0; q < 3; ++q)
#pragma unroll
            for (int b = 0; b < 16; ++b) part[(kg * 48 + cl + 16 * q) * 16 + b] = acc[q][b];
        __syncthreads();
        for (int t = F.tid; t < 768; t += 512) { const int col = t >> 4, b = t & 15; float sum = F.inp[I_BADA][l * 6144 + cbase + col];
            for (int g = 0; g < 32; ++g) sum += part[(g * 48 + col) * 16 + b];
            ((float*)(F.ws + WS_CTL + CTL_MOD))[((size_t)l * 16 + b) * 6144 + cbase + col] = sum; }
    }
}

__device__ __forceinline__ void write_normed(const f32x4 (&v)[4], float rstd, const float* g, const float* sc, const float* sh, bf16* orow, int lane) {
#pragma unroll
    for (int j = 0; j < 4; ++j) { const int c = 4 * lane + 256 * j;
        const f32x4 g4 = *(const f32x4*)(g + c), s4 = *(const f32x4*)(sc + c), h4 = *(const f32x4*)(sh + c);
        const f32x4 o = v[j] * rstd * g4 * (s4 + 1.0f) + h4;
        v2u w; w.x = pk2(o[0], o[1]); w.y = pk2(o[2], o[3]); *(v2u*)(orow + c) = w; }
}
__device__ __forceinline__ float row_rstd(const f32x4 (&v)[4]) {
    float s = 0.f;
#pragma unroll
    for (int j = 0; j < 4; ++j) s += (v[j][0] * v[j][0] + v[j][1] * v[j][1]) + (v[j][2] * v[j][2] + v[j][3] * v[j][3]);
    return 1.0f / sqrtf(wave_sum(s) * (1.0f / DM) + EPS);
}
__device__ __forceinline__ void norm_vectors(const float* g, const float* sc, const float* sh, int lane, f32x4 (&gs)[4], f32x4 (&shv)[4]) {
#pragma unroll
    for (int j = 0; j < 4; ++j) { const int c = 4 * lane + 256 * j; gs[j] = *(const f32x4*)(g + c) * (*(const f32x4*)(sc + c) + 1.0f); shv[j] = *(const f32x4*)(sh + c); }
}
__device__ __forceinline__ void store_normed(const f32x4 (&v)[4], float rstd, const f32x4 (&gs)[4], const f32x4 (&shv)[4], bf16* H, size_t row, int lane, int mode, float* hs) {
    f32x4 o[4];
#pragma unroll
    for (int j = 0; j < 4; ++j) o[j] = v[j] * rstd * gs[j] + shv[j];
    if (mode == 2) { float m = 0.f;
#pragma unroll
        for (int j = 0; j < 4; ++j) m = fmaxf(fmaxf(m, fmaxf(fabsf(o[j][0]), fabsf(o[j][1]))), fmaxf(fabsf(o[j][2]), fabsf(o[j][3])));
        m = fmaxf(wave_max_nonneg(m), 1e-20f); const float s = 127.0f / m;
#pragma unroll
        for (int j = 0; j < 4; ++j) *(unsigned*)((unsigned char*)H + row * DM + 4 * lane + 256 * j) = pk4i8(o[j][0] * s, o[j][1] * s, o[j][2] * s, o[j][3] * s);
        if (lane == 0) hs[row] = m * (1.0f / 127.0f); }
    else {
#pragma unroll
        for (int j = 0; j < 4; ++j) { if (mode == 1) *(unsigned*)((unsigned char*)H + row * DM + 4 * lane + 256 * j) = pk4f8(o[j][0], o[j][1], o[j][2], o[j][3]);
            else *(v2u*)(H + row * DM + 4 * lane + 256 * j) = (v2u){pk2(o[j][0], o[j][1]), pk2(o[j][2], o[j][3])}; } }
}
#define HMODE(l) (I8_ON(l) ? 2 : (FP8_ON(l, 0) ? 1 : 0))
__device__ __forceinline__ void p1_first_norm(Frame& F) {
    const int gw = F.vcu * NWAVES + F.wave, row0 = gw * 16, b = row0 >> 11;
    const float* mod = modp(F, 0) + b * 6144; bf16* X = wsb(F, WS_X); bf16* H = wsb(F, WS_HY);
    f32x4 gs[4], shv[4]; norm_vectors(F.inp[I_GN1], mod + 1024, mod, F.lane, gs, shv);
    for (int i = 0; i < 16; i += 2) {
        f32x4 va[4], vb[4];
#pragma unroll
        for (int j = 0; j < 4; ++j) { va[j] = __builtin_nontemporal_load((const f32x4*)(F.inp[I_X] + (size_t)(row0 + i) * DM + 4 * F.lane + 256 * j)); vb[j] = __builtin_nontemporal_load((const f32x4*)(F.inp[I_X] + (size_t)(row0 + i + 1) * DM + 4 * F.lane + 256 * j)); }
        const float ra = row_rstd(va), rb = row_rstd(vb);
#pragma unroll
        for (int j = 0; j < 4; ++j) { *(v2u*)(X + (size_t)(row0 + i) * DM + 4 * F.lane + 256 * j) = (v2u){pk2(va[j][0], va[j][1]), pk2(va[j][2], va[j][3])};
                                      *(v2u*)(X + (size_t)(row0 + i + 1) * DM + 4 * F.lane + 256 * j) = (v2u){pk2(vb[j][0], vb[j][1]), pk2(vb[j][2], vb[j][3])}; }
        store_normed(va, ra, gs, shv, HMODE(0) ? h8p(F) : H, (size_t)(row0 + i), F.lane, HMODE(0), hsp(F)); store_normed(vb, rb, gs, shv, HMODE(0) ? h8p(F) : H, (size_t)(row0 + i + 1), F.lane, HMODE(0), hsp(F));
    }
}
__device__ __forceinline__ void combine_row(const bf16* X, const bf16* YE, const float* rw, const f32x4 (&gt)[4], int row, int lane, f32x4 (&v)[4]) {
    const float w0 = rw[2 * row], w1 = rw[2 * row + 1];
#pragma unroll
    for (int j = 0; j < 4; ++j) { const int c = 4 * lane + 256 * j;
        const v2u xv = __builtin_nontemporal_load((const v2u*)(X + (size_t)row * DM + c));
        if (YE_FP8) { typedef float f32x2 __attribute__((ext_vector_type(2)));
            const unsigned q0 = *(const unsigned*)((const unsigned char*)YE + (size_t)row * DM + c), q1 = *(const unsigned*)((const unsigned char*)YE + (size_t)(NTOK + row) * DM + c);
            const f32x2 a0 = __builtin_amdgcn_cvt_pk_f32_fp8(q0, false), a1 = __builtin_amdgcn_cvt_pk_f32_fp8(q0, true), b0 = __builtin_amdgcn_cvt_pk_f32_fp8(q1, false), b1 = __builtin_amdgcn_cvt_pk_f32_fp8(q1, true);
            const float u0 = w0 * (1.0f / E8S), u1 = w1 * (1.0f / E8S);
            v[j][0] = bflo(xv.x) + gt[j][0] * (u0 * a0.x + u1 * b0.x); v[j][1] = bfhi(xv.x) + gt[j][1] * (u0 * a0.y + u1 * b0.y);
            v[j][2] = bflo(xv.y) + gt[j][2] * (u0 * a1.x + u1 * b1.x); v[j][3] = bfhi(xv.y) + gt[j][3] * (u0 * a1.y + u1 * b1.y); }
        else { const v2u y0 = __builtin_nontemporal_load((const v2u*)(YE + (size_t)row * DM + c)), y1 = __builtin_nontemporal_load((const v2u*)(YE + (size_t)(NTOK + row) * DM + c));
            v[j][0] = bflo(xv.x) + gt[j][0] * (w0 * bflo(y0.x) + w1 * bflo(y1.x)); v[j][1] = bfhi(xv.x) + gt[j][1] * (w0 * bfhi(y0.x) + w1 * bfhi(y1.x));
            v[j][2] = bflo(xv.y) + gt[j][2] * (w0 * bflo(y0.y) + w1 * bflo(y1.y)); v[j][3] = bfhi(xv.y) + gt[j][3] * (w0 * bfhi(y0.y) + w1 * bfhi(y1.y)); } }
}
__device__ __forceinline__ void p9_combine(Frame& F, int l, bool dry  ) {
    const int gw = F.vcu * NWAVES + F.wave, row0 = gw * 16, b = row0 >> 11;
    const float* mod = modp(F, l) + b * 6144; const bf16* X = wsb(F, WS_X); bf16* Xo = dry ? (bf16*)F.out : wsb(F, WS_X); bf16* H = dry ? (bf16*)F.out + (size_t)NTOK * DM : wsb(F, WS_HY); const bf16* YE = wsb(F, WS_YE);
    const float* rw = (const float*)(F.ws + WS_ROUTE + RT_W);
    f32x4 gt[4], gs[4], shv[4];
#pragma unroll
    for (int j = 0; j < 4; ++j) gt[j] = *(const f32x4*)(mod + 5120 + 4 * F.lane + 256 * j);
    if (l == NLAYER - 1) {
#pragma unroll
        for (int j = 0; j < 4; ++j) gs[j] = *(const f32x4*)(F.inp[I_GF] + 4 * F.lane + 256 * j);
    } else { const float* mod1 = modp(F, l + 1) + b * 6144; norm_vectors(F.inp[I_GN1] + (l + 1) * DM, mod1 + 1024, mod1, F.lane, gs, shv); }
    for (int i = 0; i < 16; i += 2) {
        f32x4 va[4], vb[4]; combine_row(X, YE, rw, gt, row0 + i, F.lane, va); combine_row(X, YE, rw, gt, row0 + i + 1, F.lane, vb);
        const float ra = row_rstd(va), rb = row_rstd(vb);
        if (l == NLAYER - 1) {
#pragma unroll
            for (int j = 0; j < 4; ++j) { *(f32x4*)(F.out + (size_t)(row0 + i) * DM + 4 * F.lane + 256 * j) = va[j] * ra * gs[j]; *(f32x4*)(F.out + (size_t)(row0 + i + 1) * DM + 4 * F.lane + 256 * j) = vb[j] * rb * gs[j]; }
        } else {
#pragma unroll
            for (int j = 0; j < 4; ++j) { *(v2u*)(Xo + (size_t)(row0 + i) * DM + 4 * F.lane + 256 * j) = (v2u){pk2(va[j][0], va[j][1]), pk2(va[j][2], va[j][3])};
                                          *(v2u*)(Xo + (size_t)(row0 + i + 1) * DM + 4 * F.lane + 256 * j) = (v2u){pk2(vb[j][0], vb[j][1]), pk2(vb[j][2], vb[j][3])}; }
            store_normed(va, ra, gs, shv, HMODE(l + 1) ? h8p(F) : H, (size_t)(row0 + i), F.lane, HMODE(l + 1), hsp(F)); store_normed(vb, rb, gs, shv, HMODE(l + 1) ? h8p(F) : H, (size_t)(row0 + i + 1), F.lane, HMODE(l + 1), hsp(F));
        }
    }
}
constexpr int P64 = 144, P128 = 272;
typedef unsigned short u16x4 __attribute__((ext_vector_type(4)));
__device__ __forceinline__ bf16x8 ldfrag(const LAS unsigned char* tile, int pitch, int r0, int k0, int fr, int fq) { return *(const LAS bf16x8*)(tile + (r0 + fr) * pitch + (k0 + 8 * fq) * 2); }
__device__ __forceinline__ f32x4 mma16(bf16x8 a, bf16x8 b, f32x4 c) { return __builtin_amdgcn_mfma_f32_16x16x32_bf16(b, a, c, 0, 0, 0); }
__device__ __forceinline__ void lbar() { asm volatile("s_waitcnt lgkmcnt(0)" ::: "memory"); __builtin_amdgcn_s_barrier(); asm volatile("" ::: "memory"); }
__device__ __forceinline__ void trfrag2(unsigned a0, unsigned a1, unsigned b0, unsigned b1, bf16x8& fa, bf16x8& fb) {
    u16x4 r0, r1, r2, r3;
    asm volatile("ds_read_b64_tr_b16 %0, %4\n\tds_read_b64_tr_b16 %1, %5\n\tds_read_b64_tr_b16 %2, %6\n\tds_read_b64_tr_b16 %3, %7\n\ts_waitcnt lgkmcnt(0)"
                 : "=&v"(r0), "=&v"(r1), "=&v"(r2), "=&v"(r3) : "v"(a0), "v"(a1), "v"(b0), "v"(b1) : "memory");
    fa = __builtin_bit_cast(bf16x8, __builtin_shufflevector(r0, r1, 0, 1, 2, 3, 4, 5, 6, 7)); fb = __builtin_bit_cast(bf16x8, __builtin_shufflevector(r2, r3, 0, 1, 2, 3, 4, 5, 6, 7));
}
__device__ __forceinline__ unsigned offb(unsigned row, unsigned ch) { return 256u * row + 16u * (ch ^ (((row & 3) << 2) | ((row >> 2) & 3))); }
constexpr int MX_TB = 0  , MX_SSQ = 5120, MX_GG = 5632  , MX_QT = 8192, MX_KT = MX_QT + 64 * P64, MX_QH = MX_KT + 64 * P64, MX_SC = MX_QH + 64 * P64,
              MX_ST = MX_SC + 64 * P64, MX_VI = MX_ST + 128 * P64, MX_WG = MX_VI + 64 * 256  , MX_BGL = MX_WG + 8192  , MX_END = MX_BGL + 1024;
constexpr int MS_KI = 8192, MS_VI = MS_KI + 64 * P64, MS_SET = 64 * P64 + 64 * 80;
constexpr int MX_VN = 8192;
static_assert(MX_END <= RING_BYTES && MX_VN + 256 * P128 <= RING_BYTES && (MX_VI & 255) == 0, "mixer LDS");

__device__ __forceinline__ void gate_stage(Frame& F, int l) {
    *(LAS v4u*)(F.lds + MX_WG + F.tid * 16) = *(const v4u*)(wsb(F, WS_WG) + (size_t)l * 4096 + F.tid * 8);
    if (F.tid < 256) ((LAS float*)(F.lds + MX_BGL))[F.tid] = F.inp[I_BGATE][l * 256 + F.tid];
}
__device__ __forceinline__ v4u gate_load(Frame& F, int tok0) {
    const int fr = F.lane & 15, fq = F.lane >> 4, mt = F.wave >> 1;
    return *(const v4u*)(wsb(F, WS_P) + (size_t)(tok0 + 16 * mt + fr) * PNP + PC_G + 8 * (fq & 1));
}
__device__ __forceinline__ void gate_prefix(Frame& F, const v4u ga, int h, float (&pb)[2][4], LAS float* tb) {
    const int fr = F.lane & 15, fq = F.lane >> 4, mt = F.wave >> 1, nt0 = 2 * (F.wave & 1);
    const v4u zero4 = (v4u){0u, 0u, 0u, 0u};
    const bf16x8 a = __builtin_bit_cast(bf16x8, (fq < 2) ? ga : zero4);
#pragma unroll
    for (int q = 0; q < 2; ++q) { const int kt = h * 64 + 16 * (nt0 + q);
        const v4u wv = *(const LAS v4u*)(F.lds + MX_WG + ((kt + fr) * 16 + 8 * (fq & 1)) * 2);
        const bf16x8 bw = __builtin_bit_cast(bf16x8, (fq < 2) ? wv : zero4);
        const f32x4 z = mma16(a, bw, *(const LAS f32x4*)(F.lds + MX_BGL + (kt + 4 * fq) * 4));
#pragma unroll
        for (int r = 0; r < 4; ++r) { float x = (fminf(z[r], 0.f) - flog(1.0f + fexp(-fabsf(z[r])))) * (1.0f / 16.0f);
            pb[q][r] = row_prefix16(x); }
        const int k0 = 16 * (nt0 + q) + 4 * fq;
        if (fr == 15) *(LAS f32x4*)(tb + mt * 64 + k0) = (f32x4){pb[q][0], pb[q][1], pb[q][2], pb[q][3]};
        if (mt == 2 && fr == 0) *(LAS f32x4*)(tb + 256 + k0) = (f32x4){pb[q][0], pb[q][1], pb[q][2], pb[q][3]}; }
}
__device__ __forceinline__ void gate_finish(Frame& F, const LAS float* tb, float (&pb)[2][4], float (&bref)[2][4], float (&blast)[2][4]) {
    const int fq = F.lane >> 4, mt = F.wave >> 1, nt0 = 2 * (F.wave & 1);
#pragma unroll
    for (int q = 0; q < 2; ++q) { const int k0 = 16 * (nt0 + q) + 4 * fq;
        const f32x4 t0 = *(const LAS f32x4*)(tb + k0), t1 = *(const LAS f32x4*)(tb + 64 + k0), t2 = *(const LAS f32x4*)(tb + 128 + k0), t3 = *(const LAS f32x4*)(tb + 192 + k0), g32 = *(const LAS f32x4*)(tb + 256 + k0);
#pragma unroll
        for (int r = 0; r < 4; ++r) { const float off = ((mt > 0) ? t0[r] : 0.f) + ((mt > 1) ? t1[r] : 0.f) + ((mt > 2) ? t2[r] : 0.f);
            pb[q][r] += off; bref[q][r] = t0[r] + t1[r] + g32[r]; blast[q][r] = (t0[r] + t1[r]) + (t2[r] + t3[r]); } }
}

__device__ __forceinline__ bf16* gla_arr(const Frame& F, int which) { return (bf16*)F.out + (size_t)(16 + 8 * which) * 1024 * 1024; }
struct PrepIn { v4u ga; v2u q[2], k[2]; };
__device__ __forceinline__ void prep_load(Frame& F, int item, PrepIn& p) {
    const int fr = F.lane & 15, fq = F.lane >> 4, mt = F.wave >> 1, nt0 = 2 * (F.wave & 1), h = item & 3, tok0 = (item >> 2) * 64;
    p.ga = gate_load(F, tok0);
    const bf16* pr = wsb(F, WS_P) + (size_t)(tok0 + 16 * mt + fr) * PNP + h * 64 + 4 * fq;
#pragma unroll
    for (int q = 0; q < 2; ++q) { p.q[q] = *(const v2u*)(pr + PC_Q + 16 * (nt0 + q)); p.k[q] = *(const v2u*)(pr + PC_K + 16 * (nt0 + q)); }
}
__device__ __forceinline__ void p3p_gla_prep(Frame& F, int l) {
    const int fr = F.lane & 15, fq = F.lane >> 4, w = F.wave, mt = w >> 1, nt0 = 2 * (w & 1);
    PrepIn ring[3]; prep_load(F, F.vcu * 8, ring[0]); prep_load(F, F.vcu * 8 + 1, ring[1]); ring[2] = ring[0];
    bf16* QT = gla_arr(F, 0); bf16* KT = gla_arr(F, 1); bf16* QH = gla_arr(F, 2); bf16* KH = gla_arr(F, 3); float* dec = (float*)(F.ws + WS_ROUTE + RT_DEC);
    __syncthreads();
    gate_stage(F, l);
    __syncthreads();
    for (int i3 = 0; i3 < 9; i3 += 3) {
#pragma unroll
      for (int j = 0; j < 3; ++j) { const int ii = i3 + j; if (ii < 8) {
        const PrepIn& cur = ring[j];
        const int item = F.vcu * 8 + ii, h = item & 3, tok0 = (item >> 2) * 64;
        LAS float* tb = (LAS float*)(F.lds + MX_TB) + (ii & 1) * 320;
        float pb[2][4], bref[2][4], blast[2][4];
        gate_prefix(F, cur.ga, h, pb, tb);
        lbar();
        gate_finish(F, tb, pb, bref, blast);
#pragma unroll
        for (int q = 0; q < 2; ++q) { const size_t off = (size_t)(tok0 + 16 * mt + fr) * 256 + h * 64 + 16 * (nt0 + q) + 4 * fq;
            const float q0 = bflo(cur.q[q].x) * 0.125f, q1 = bfhi(cur.q[q].x) * 0.125f, q2 = bflo(cur.q[q].y) * 0.125f, q3 = bfhi(cur.q[q].y) * 0.125f;
            const float k0 = bflo(cur.k[q].x), k1 = bfhi(cur.k[q].x), k2 = bflo(cur.k[q].y), k3 = bfhi(cur.k[q].y);
            const float e0 = fexp(pb[q][0] - bref[q][0]), e1 = fexp(pb[q][1] - bref[q][1]), e2 = fexp(pb[q][2] - bref[q][2]), e3 = fexp(pb[q][3] - bref[q][3]);
            *(v2u*)(QT + off) = (v2u){pk2(q0 * e0, q1 * e1), pk2(q2 * e2, q3 * e3)};
            *(v2u*)(KT + off) = (v2u){pk2(k0 * fexp(bref[q][0] - pb[q][0]), k1 * fexp(bref[q][1] - pb[q][1])), pk2(k2 * fexp(bref[q][2] - pb[q][2]), k3 * fexp(bref[q][3] - pb[q][3]))};
            *(v2u*)(QH + off) = (v2u){pk2(q0 * fexp(pb[q][0]), q1 * fexp(pb[q][1])), pk2(q2 * fexp(pb[q][2]), q3 * fexp(pb[q][3]))};
            *(v2u*)(KH + off) = (v2u){pk2(k0 * fexp(blast[q][0] - pb[q][0]), k1 * fexp(blast[q][1] - pb[q][1])), pk2(k2 * fexp(blast[q][2] - pb[q][2]), k3 * fexp(blast[q][3] - pb[q][3]))};
            if (mt == 0 && fr == 0) *(f32x4*)(dec + item * 64 + 16 * (nt0 + q) + 4 * fq) = (f32x4){fexp(blast[q][0]), fexp(blast[q][1]), fexp(blast[q][2]), fexp(blast[q][3])}; }
        if (ii + 2 < 8) prep_load(F, item + 2, ring[(j + 2) % 3]);
      } }
    }
}

struct StateIn { v4u kh; v4u v; f32x4 dc; };
__device__ __forceinline__ void state_load(Frame& F, int b, int n, int h, int vq, StateIn& s) {
    const int fq = F.lane >> 4, ntk = F.wave & 3; const int tok0 = b * SEQ + 64 * n, item = (b * 32 + n) * 4 + h;
    s.kh = *(const v4u*)(gla_arr(F, 3) + (size_t)(tok0 + (F.tid >> 3)) * 256 + h * 64 + 8 * (F.tid & 7));
    const int c = F.tid & 255; s.v = *(const v4u*)(wsb(F, WS_P) + (size_t)(tok0 + (c >> 2)) * PNP + PC_V + h * 128 + 32 * vq + 8 * (c & 3));
    s.dc = *(const f32x4*)((const float*)(F.ws + WS_ROUTE + RT_DEC) + item * 64 + 16 * ntk + 4 * fq);
}
__device__ __forceinline__ void p3a_gla_state(Frame& F, int l, int var) {
    const int fr = F.lane & 15, fq = F.lane >> 4, w = F.wave, mtv = w >> 2, ntk = w & 3;
    const int b = F.vcu >> 4, h = (F.vcu >> 2) & 3, vq = F.vcu & 3;
    StateIn ring[6];
#pragma unroll
    for (int j = 0; j < 6; ++j) state_load(F, b, j, h, vq, ring[j]);
    f32x4 S = (f32x4){0.f, 0.f, 0.f, 0.f};
    const unsigned rq = (unsigned)(8 * fq + (fr >> 2)), cp = (unsigned)(4 * (fr & 3));
    const unsigned av = (unsigned)MS_VI + rq * 80u + (16u * mtv + cp) * 2u, ak = (unsigned)MS_KI + rq * (unsigned)P64 + (16u * ntk + cp) * 2u;
    bf16* kvo = (bf16*)F.out;
    __syncthreads();
    for (int n6 = 0; n6 < 36; n6 += 6) {
#pragma unroll
      for (int j = 0; j < 6; j += 2) { const int n = n6 + j; if (n < 32) {
        const unsigned sb = (unsigned)(((n >> 1) & 1) * 2 * MS_SET);
        *(LAS v4u*)(F.lds + sb + MS_KI + (F.tid >> 3) * P64 + (F.tid & 7) * 16) = ring[j].kh; *(LAS v4u*)(F.lds + sb + MS_KI + MS_SET + (F.tid >> 3) * P64 + (F.tid & 7) * 16) = ring[j + 1].kh;
        if (F.tid < 256) { *(LAS v4u*)(F.lds + sb + MS_VI + (F.tid >> 2) * 80 + (F.tid & 3) * 16) = ring[j].v; *(LAS v4u*)(F.lds + sb + MS_VI + MS_SET + (F.tid >> 2) * 80 + (F.tid & 3) * 16) = ring[j + 1].v; }
        const f32x4 d0 = ring[j].dc, d1 = ring[j + 1].dc;
        if (n + 6 < 32 && var != 1) { state_load(F, b, n + 6, h, vq, ring[j]); state_load(F, b, n + 7, h, vq, ring[j + 1]); }
        lbar();
        f32x4 kv0 = (f32x4){0.f, 0.f, 0.f, 0.f}, kv1 = kv0;
#pragma unroll
        for (int ks = 0; ks < 2; ++ks) { bf16x8 fa, fb; const unsigned oa = sb + ks * 32u * 80u, ob = sb + ks * 32u * (unsigned)P64;
            trfrag2(av + oa, av + oa + 4u * 80u, ak + ob, ak + ob + 4u * (unsigned)P64, fa, fb); kv0 = mma16(fa, fb, kv0);
            trfrag2(av + (unsigned)MS_SET + oa, av + (unsigned)MS_SET + oa + 4u * 80u, ak + (unsigned)MS_SET + ob, ak + (unsigned)MS_SET + ob + 4u * (unsigned)P64, fa, fb); kv1 = mma16(fa, fb, kv1); }
        const size_t o0 = (size_t)((b * 32 + n) * 4 + h) * 8192 + (32 * vq + 16 * mtv + fr) * 64 + 16 * ntk + 4 * fq;
        if (var != 2) *(v2u*)(kvo + o0) = (v2u){pk2(S[0], S[1]), pk2(S[2], S[3])};
        S = d0 * S + kv0;
        if (var != 2) *(v2u*)(kvo + o0 + 4 * 8192) = (v2u){pk2(S[0], S[1]), pk2(S[2], S[3])};
        S = d1 * S + kv1;
      } }
    }
}

constexpr int MO_BASE = 8192, MO_HALF = 71680;
constexpr int MO_QT = 0, MO_KT = 9216, MO_QH = 18432, MO_SC = 27648, MO_ST = 36864, MO_VI = 55296;
static_assert(MO_BASE + 2 * MO_HALF <= LDSCTL_OFF && ((MO_BASE + MO_VI) & 255) == 0 && (MO_HALF & 255) == 0, "mixer-out LDS");
struct OutIn { v4u qt[2], kt[2], qh[2]; v4u v[4]; v4u s[4]; };
__device__ __forceinline__ void out_load(Frame& F, int item, OutIn& o) {
    const int h = item & 3, tok0 = (item >> 2) * 64, t8 = F.tid & 255;
    const bf16* P = wsb(F, WS_P);
#pragma unroll
    for (int i = 0; i < 2; ++i) { const int c = t8 + 256 * i; const size_t go = (size_t)(tok0 + (c >> 3)) * 256 + h * 64 + 8 * (c & 7);
        o.qt[i] = __builtin_nontemporal_load((const v4u*)(gla_arr(F, 0) + go)); o.kt[i] = __builtin_nontemporal_load((const v4u*)(gla_arr(F, 1) + go)); o.qh[i] = __builtin_nontemporal_load((const v4u*)(gla_arr(F, 2) + go)); }
#pragma unroll
    for (int i = 0; i < 4; ++i) { const int c = t8 + 256 * i; o.v[i] = __builtin_nontemporal_load((const v4u*)(P + (size_t)(tok0 + (c >> 4)) * PNP + PC_V + h * 128 + 8 * (c & 15)));
        o.s[i] = __builtin_nontemporal_load((const v4u*)((const bf16*)F.out + (size_t)item * 8192 + (size_t)c * 8)); }
}
__device__ __forceinline__ void p3c_mixer_out(Frame& F, int l) {
    const int fr = F.lane & 15, fq = F.lane >> 4, w = F.wave, half = w >> 2, mt = w & 3, t8 = F.tid & 255;
    const bf16* P = wsb(F, WS_P); bf16* Y = wsb(F, WS_HY); unsigned char* Y8 = F.ws + WS_HY; const bool y8 = FP8_ON(l, 1);
    {
    LAS unsigned char* L = F.lds + MO_BASE + half * MO_HALF;
    const unsigned lvi = (unsigned)(MO_BASE + half * MO_HALF + MO_VI);
    OutIn cur;
    out_load(F, F.vcu * 8 + half, cur);
    const unsigned rq = (unsigned)(8 * fq + (fr >> 2)), ch0 = (unsigned)((fr & 3) >> 1), c8 = (unsigned)(8 * (fr & 1));
    __syncthreads();
    ((LAS float*)(F.lds + MX_GG))[F.tid] = F.inp[I_GLAG][l * 512 + F.tid];
    for (int it = 0; it < 4; ++it) {
      {
        const int item = F.vcu * 8 + 2 * it + half, h = item & 3, tok0 = (item >> 2) * 64;
        const int i = 16 * mt + fr;
        v2u ogv[8];
#pragma unroll
        for (int q = 0; q < 8; ++q) ogv[q] = *(const v2u*)(P + (size_t)(tok0 + i) * PNP + PC_OG + h * 128 + 16 * q + 4 * fq);
        lbar();
#pragma unroll
        for (int k = 0; k < 2; ++k) { const int c = t8 + 256 * k, to = (c >> 3) * P64 + (c & 7) * 16;
            *(LAS v4u*)(L + MO_QT + to) = cur.qt[k]; *(LAS v4u*)(L + MO_KT + to) = cur.kt[k]; *(LAS v4u*)(L + MO_QH + to) = cur.qh[k]; }
#pragma unroll
        for (int k = 0; k < 4; ++k) { const unsigned c = (unsigned)(t8 + 256 * k); *(LAS v4u*)(L + MO_VI + offb(c >> 4, c & 15)) = cur.v[k];
            *(LAS v4u*)(L + MO_ST + (c >> 3) * P64 + (c & 7) * 16) = cur.s[k]; }
        if (it + 1 < 4) out_load(F, item + 2, cur);
        lbar();
        {
          const bf16x8 a0 = ldfrag(L + MO_QT, P64, 16 * mt, 0, fr, fq), a1 = ldfrag(L + MO_QT, P64, 16 * mt, 32, fr, fq);
#pragma unroll
          for (int nt = 0; nt < 4; ++nt) { f32x4 c = (f32x4){0.f, 0.f, 0.f, 0.f};
              c = mma16(a0, ldfrag(L + MO_KT, P64, 16 * nt, 0, fr, fq), c); c = mma16(a1, ldfrag(L + MO_KT, P64, 16 * nt, 32, fr, fq), c);
              const int j0 = 16 * nt + 4 * fq;
              const float c0 = (j0 + 0 <= i) ? c[0] : 0.f, c1 = (j0 + 1 <= i) ? c[1] : 0.f, c2 = (j0 + 2 <= i) ? c[2] : 0.f, c3 = (j0 + 3 <= i) ? c[3] : 0.f;
              *(LAS v2u*)(L + MO_SC + i * P64 + 2 * j0) = (v2u){pk2(c0, c1), pk2(c2, c3)}; } }
        lbar();
        f32x4 acc[8];
#pragma unroll
        for (int q = 0; q < 8; ++q) acc[q] = (f32x4){0.f, 0.f, 0.f, 0.f};
#pragma unroll
        for (int ks = 0; ks < 2; ++ks) { const bf16x8 a1 = ldfrag(L + MO_SC, P64, 16 * mt, 32 * ks, fr, fq), a2 = ldfrag(L + MO_QH, P64, 16 * mt, 32 * ks, fr, fq);
            const unsigned r0 = 32u * ks + rq, r1 = r0 + 4u;
#pragma unroll
            for (int q = 0; q < 8; q += 2) { const unsigned cA = 2u * q + ch0, cB = cA + 2u; bf16x8 va, vb;
                trfrag2(lvi + offb(r0, cA) + c8, lvi + offb(r1, cA) + c8, lvi + offb(r0, cB) + c8, lvi + offb(r1, cB) + c8, va, vb);
                acc[q] = mma16(a1, va, acc[q]); acc[q + 1] = mma16(a1, vb, acc[q + 1]); }
#pragma unroll
            for (int q = 0; q < 8; ++q) acc[q] = mma16(a2, ldfrag(L + MO_ST, P64, 16 * q, 32 * ks, fr, fq), acc[q]); }
        float ss = 0.f;
#pragma unroll
        for (int q = 0; q < 8; ++q) ss += (acc[q][0] * acc[q][0] + acc[q][1] * acc[q][1]) + (acc[q][2] * acc[q][2] + acc[q][3] * acc[q][3]);
        ss += __shfl_xor(ss, 16); ss += __shfl_xor(ss, 32);
        const float rn = 1.0f / sqrtf(ss * (1.0f / 128.0f) + EPS);
#pragma unroll
        for (int q = 0; q < 8; ++q) { const int col = h * 128 + 16 * q + 4 * fq; const size_t tok = (size_t)(tok0 + i);
            const v2u og = ogv[q]; const f32x4 gg = *(const LAS f32x4*)(F.lds + MX_GG + col * 4);
            const float o0 = bflo(og.x), o1 = bfhi(og.x), o2 = bflo(og.y), o3 = bfhi(og.y);
            const float y0 = acc[q][0] * rn * gg[0] * o0 * __builtin_amdgcn_rcpf(1.0f + fexp(-o0)), y1 = acc[q][1] * rn * gg[1] * o1 * __builtin_amdgcn_rcpf(1.0f + fexp(-o1));
            const float y2 = acc[q][2] * rn * gg[2] * o2 * __builtin_amdgcn_rcpf(1.0f + fexp(-o2)), y3 = acc[q][3] * rn * gg[3] * o3 * __builtin_amdgcn_rcpf(1.0f + fexp(-o3));
            if (y8) *(unsigned*)(Y8 + tok * DM + 256 + col) = pk4f8(y0 * Y8S, y1 * Y8S, y2 * Y8S, y3 * Y8S); else *(v2u*)(Y + tok * DM + 256 + col) = (v2u){pk2(y0, y1), pk2(y2, y3)}; }
      }
    }
    }
    const int tokb = F.vcu * 128;
    __syncthreads();
    const bf16* GWp = wsb(F, WS_GW) + (size_t)l * 4 * 128 * 128; const int gt = 16 * w + fr;
    bf16x8 gaw[4][4]; v2u guu[4][4]; float gbs[4];
    {
      const f32x4 lg4 = *(const f32x4*)(F.inp[I_LNG] + l * 256 + 4 * F.lane), lb4 = *(const f32x4*)(F.inp[I_LNB] + l * 256 + 4 * F.lane);
      v2u xin[16];
#pragma unroll
      for (int i = 0; i < 16; ++i) xin[i] = *(const v2u*)(P + (size_t)(tokb + 16 * w + i) * PNP + PC_VV + 4 * F.lane);
#pragma unroll
      for (int h = 0; h < 4; ++h) { gbs[h] = F.inp[I_GBS][(l * 4 + h) * 128 + gt];
#pragma unroll
          for (int ks = 0; ks < 4; ++ks) gaw[h][ks] = *(const bf16x8*)(GWp + ((size_t)h * 128 + gt) * 128 + 32 * ks + 8 * fq);
#pragma unroll
          for (int q = 0; q < 4; ++q) guu[h][q] = *(const v2u*)(P + (size_t)(tokb + gt) * PNP + PC_U + h * 64 + 16 * q + 4 * fq); }
      unsigned o[4][8];
#pragma unroll
      for (int i = 0; i < 16; i += 2) { float y[2][4];
#pragma unroll
          for (int e = 0; e < 2; ++e) { float x[4] = {bflo(xin[i + e].x), bfhi(xin[i + e].x), bflo(xin[i + e].y), bfhi(xin[i + e].y)};
              const float mu = wave_sum((x[0] + x[1]) + (x[2] + x[3])) * (1.0f / 256.0f); float vr = 0.f;
#pragma unroll
              for (int q = 0; q < 4; ++q) { x[q] -= mu; vr += x[q] * x[q]; }
              const float rs = 1.0f / sqrtf(wave_sum(vr) * (1.0f / 256.0f) + EPS);
#pragma unroll
              for (int q = 0; q < 4; ++q) y[e][q] = x[q] * rs * lg4[q] + lb4[q]; }
#pragma unroll
          for (int q = 0; q < 4; ++q) o[q][i >> 1] = pk2(y[0][q], y[1][q]); }
#pragma unroll
      for (int q = 0; q < 4; ++q) { LAS unsigned char* d = F.lds + MX_VN + (4 * F.lane + q) * P128 + 32 * w;
          *(LAS v4u*)d = (v4u){o[q][0], o[q][1], o[q][2], o[q][3]}; *(LAS v4u*)(d + 16) = (v4u){o[q][4], o[q][5], o[q][6], o[q][7]}; } }
    __syncthreads();
    { const size_t tok = (size_t)(tokb + gt);
      const int nks = (w < 4) ? 2 : 4;
#pragma unroll
      for (int h = 0; h < 4; ++h) {
          f32x4 acc[4];
#pragma unroll
          for (int q = 0; q < 4; ++q) acc[q] = (f32x4){0.f, 0.f, 0.f, 0.f};
#pragma unroll
          for (int ks = 0; ks < 4; ++ks) { if (ks < nks) {
#pragma unroll
              for (int q = 0; q < 4; ++q) acc[q] = mma16(gaw[h][ks], ldfrag(F.lds + MX_VN, P128, h * 64 + 16 * q, 32 * ks, fr, fq), acc[q]); } }
          const float bs = gbs[h];
#pragma unroll
          for (int q = 0; q < 4; ++q) { const int c = h * 64 + 16 * q + 4 * fq; const v2u u = guu[h][q];
              const float a0 = bflo(u.x) * (acc[q][0] + bs), a1 = bfhi(u.x) * (acc[q][1] + bs), a2 = bflo(u.y) * (acc[q][2] + bs), a3 = bfhi(u.y) * (acc[q][3] + bs);
              if (y8) *(unsigned*)(Y8 + tok * DM + c) = pk4f8(a0 * Y8S, a1 * Y8S, a2 * Y8S, a3 * Y8S); else *(v2u*)(Y + tok * DM + c) = (v2u){pk2(a0, a1), pk2(a2, a3)}; }
      } }
    { const int c = (F.tid & 31) * 8, tg = F.tid >> 5;
      float cw0[8], cw1[8], cw2[8], cbb[8];
#pragma unroll
      for (int e = 0; e < 8; ++e) { const float* cw = F.inp[I_CONVW] + l * 3 * 256 + c + e; cw0[e] = cw[0]; cw1[e] = cw[256]; cw2[e] = cw[512]; cbb[e] = F.inp[I_CONVB][l * 256 + c + e]; }
      const size_t tok0 = (size_t)(tokb + 8 * tg); const int tseq0 = (int)(tok0 & (SEQ - 1));
      v4u ca[10], cxv[10], gbv[8];
#pragma unroll
      for (int j = 0; j < 10; ++j) { const bool ok = (j >= 2) || (tseq0 + j - 2 >= 0);
          if (ok) { ca[j] = *(const v4u*)(P + (tok0 + j - 2) * PNP + PC_CC + c); cxv[j] = *(const v4u*)(P + (tok0 + j - 2) * PNP + PC_CX + c); }
          else { ca[j] = (v4u){0u, 0u, 0u, 0u}; cxv[j] = (v4u){0u, 0u, 0u, 0u}; } }
#pragma unroll
      for (int k = 0; k < 8; ++k) gbv[k] = __builtin_nontemporal_load((const v4u*)(P + (tok0 + k) * PNP + PC_CB + c));
      float z[10][8];
#pragma unroll
      for (int j = 0; j < 10; ++j) { const v4u a = ca[j], x = cxv[j];
          z[j][0] = bflo(a.x) * bflo(x.x); z[j][1] = bfhi(a.x) * bfhi(x.x); z[j][2] = bflo(a.y) * bflo(x.y); z[j][3] = bfhi(a.y) * bfhi(x.y);
          z[j][4] = bflo(a.z) * bflo(x.z); z[j][5] = bfhi(a.z) * bfhi(x.z); z[j][6] = bflo(a.w) * bflo(x.w); z[j][7] = bfhi(a.w) * bfhi(x.w); }
#pragma unroll
      for (int k = 0; k < 8; ++k) { const size_t tok = tok0 + k; const v4u gb = gbv[k];
        const float cbv[8] = {bflo(gb.x), bfhi(gb.x), bflo(gb.y), bfhi(gb.y), bflo(gb.z), bfhi(gb.z), bflo(gb.w), bfhi(gb.w)};
        float y[8];
#pragma unroll
        for (int e = 0; e < 8; ++e) y[e] = cbv[e] * (cbb[e] + cw0[e] * z[k][e] + cw1[e] * z[k + 1][e] + cw2[e] * z[k + 2][e]);
        if (y8) *(v2u*)(Y8 + tok * DM + 768 + c) = (v2u){pk4f8(y[0] * Y8S, y[1] * Y8S, y[2] * Y8S, y[3] * Y8S), pk4f8(y[4] * Y8S, y[5] * Y8S, y[6] * Y8S, y[7] * Y8S)};
        else *(v4u*)(Y + tok * DM + 768 + c) = (v4u){pk2(y[0], y[1]), pk2(y[2], y[3]), pk2(y[4], y[5]), pk2(y[6], y[7])}; } }
}
constexpr int LT_CNT = 0, LT_BASE = 32, LT_SEG = 64, LT_REC = 128, LT_TILE = 1280, LT_ROW = 1664;
static_assert(LTAB_OFF + (LT_ROW + 5 * 256) * 4 <= LDSCTL_OFF, "LTAB");
__device__ __forceinline__ void norm2_vectors(Frame& F, int l, int b, f32x4 (&gs)[4], f32x4 (&sh)[4]) {
    const float* mod = modp(F, l) + b * 6144;
#pragma unroll
    for (int j = 0; j < 4; ++j) { const int c = 4 * F.lane + 256 * j; const f32x4 g4 = *(const f32x4*)(F.inp[I_GN2] + l * DM + c), s4 = *(const f32x4*)(mod + 4096 + c);
        gs[j] = g4 * (s4 + 1.0f); sh[j] = *(const f32x4*)(mod + 3072 + c); }
}
__device__ __forceinline__ void load_xrow(const bf16* X, size_t row, int lane, f32x4 (&v)[4]) {
#pragma unroll
    for (int j = 0; j < 4; ++j) { const v2u xv = *(const v2u*)(X + row * DM + 4 * lane + 256 * j); v[j] = (f32x4){bflo(xv.x), bfhi(xv.x), bflo(xv.y), bfhi(xv.y)}; }
}
constexpr int RW_PITCH = 2064;
constexpr int R_GS = 32 * RW_PITCH, R_SH = R_GS + 4096, R_LG = R_SH + 4096, R_RS = R_LG + 128 * 33 * 4, R_END = R_RS + 512;
static_assert(R_END <= LTAB_OFF, "router LDS");
__device__ __forceinline__ void p5a_route(Frame& F, int l, int cslot  ) {
    LAS unsigned* lt = (LAS unsigned*)(F.lds + LTAB_OFF);
    LAS float* gsl = (LAS float*)(F.lds + R_GS); LAS float* shl = (LAS float*)(F.lds + R_SH); LAS float* lgl = (LAS float*)(F.lds + R_LG); LAS float* rsl = (LAS float*)(F.lds + R_RS);
    const int tokb = F.vcu * 128, b = tokb >> 11, fr = F.lane & 15, fq = F.lane >> 4; const bf16* X = wsb(F, WS_X);
    __syncthreads();
    { const v4u* src = (const v4u*)(F.ws + WS_WR);
#pragma unroll
      for (int i = 0; i < 8; ++i) { const int c = F.tid + 512 * i; *(LAS v4u*)(F.lds + (c >> 7) * RW_PITCH + (c & 127) * 16) = src[c]; }
      const float* mod = modp(F, l) + b * 6144;
      for (int k = F.tid; k < DM; k += 512) { gsl[k] = F.inp[I_GN2][l * DM + k] * (mod[4096 + k] + 1.0f); shl[k] = mod[3072 + k]; }
      if (F.tid < 32) lt[LT_CNT + F.tid] = 0u; }
    __syncthreads();
    float myrs = 0.f;
    for (int i = 0; i < 16; i += 4) { f32x4 v0[4], v1[4], v2[4], v3[4];
        load_xrow(X, (size_t)(tokb + 16 * F.wave + i), F.lane, v0); load_xrow(X, (size_t)(tokb + 16 * F.wave + i + 1), F.lane, v1);
        load_xrow(X, (size_t)(tokb + 16 * F.wave + i + 2), F.lane, v2); load_xrow(X, (size_t)(tokb + 16 * F.wave + i + 3), F.lane, v3);
        const float r0 = row_rstd(v0), r1 = row_rstd(v1), r2 = row_rstd(v2), r3 = row_rstd(v3);
        myrs = (fr == i) ? r0 : (fr == i + 1) ? r1 : (fr == i + 2) ? r2 : (fr == i + 3) ? r3 : myrs; }
    if (fq == 0) rsl[16 * F.wave + fr] = myrs;
    f32x4 acc0 = (f32x4){0.f, 0.f, 0.f, 0.f}, acc1 = acc0;
    const bf16* xr = X + (size_t)(tokb + 16 * F.wave + fr) * DM + 8 * fq;
#pragma unroll 4
    for (int ks = 0; ks < 32; ++ks) { const v4u xv = *(const v4u*)(xr + 32 * ks); const int k0 = 32 * ks + 8 * fq;
        const f32x4 g0 = *(const LAS f32x4*)(gsl + k0), g1 = *(const LAS f32x4*)(gsl + k0 + 4), s0 = *(const LAS f32x4*)(shl + k0), s1 = *(const LAS f32x4*)(shl + k0 + 4);
        v4u hv;
        hv.x = pk2(bflo(xv.x) * myrs * g0[0] + s0[0], bfhi(xv.x) * myrs * g0[1] + s0[1]); hv.y = pk2(bflo(xv.y) * myrs * g0[2] + s0[2], bfhi(xv.y) * myrs * g0[3] + s0[3]);
        hv.z = pk2(bflo(xv.z) * myrs * g1[0] + s1[0], bfhi(xv.z) * myrs * g1[1] + s1[1]); hv.w = pk2(bflo(xv.w) * myrs * g1[2] + s1[2], bfhi(xv.w) * myrs * g1[3] + s1[3]);
        if (FP8_ON(l, 2)) *(v2u*)((unsigned char*)(F.ws + WS_H2) + (size_t)(tokb + 16 * F.wave + fr) * DM + k0) = (v2u){pk4f8(bflo(hv.x), bfhi(hv.x), bflo(hv.y), bfhi(hv.y)), pk4f8(bflo(hv.z), bfhi(hv.z), bflo(hv.w), bfhi(hv.w))};
        else *(v4u*)(wsb(F, WS_H2) + (size_t)(tokb + 16 * F.wave + fr) * DM + k0) = hv;
        const bf16x8 a = __builtin_bit_cast(bf16x8, hv);
        acc0 = mma16(a, ldfrag(F.lds, RW_PITCH, 0, 32 * ks, fr, fq), acc0); acc1 = mma16(a, ldfrag(F.lds, RW_PITCH, 16, 32 * ks, fr, fq), acc1); }
    { LAS float* lr = lgl + (16 * F.wave + fr) * 33 + 4 * fq;
      lr[0] = acc0[0]; lr[1] = acc0[1]; lr[2] = acc0[2]; lr[3] = acc0[3]; lr[16] = acc1[0]; lr[17] = acc1[1]; lr[18] = acc1[2]; lr[19] = acc1[3]; }
    __syncthreads();
    if (F.tid < 128) {
        float lg[32]; float mx = -3.0e38f;
#pragma unroll
        for (int e = 0; e < 32; ++e) { lg[e] = lgl[F.tid * 33 + e] + F.inp[I_RB][e]; mx = fmaxf(mx, lg[e]); }
#pragma unroll
        for (int e = 0; e < 32; ++e) lg[e] = __expf(lg[e] - mx);
        float bt1 = 0.f, bt2 = 0.f, bgs = -1.f; int bi1 = 0, bi2 = 0, bg = 0;
#pragma unroll
        for (int g = 0; g < 4; ++g) { float t1 = -1.f, t2 = -1.f; int i1 = 0, i2 = 0;
#pragma unroll
            for (int i = 0; i < 8; ++i) { const float v = lg[8 * g + i];
                if (v > t1) { t2 = t1; i2 = i1; t1 = v; i1 = i; } else if (v > t2) { t2 = v; i2 = i; } }
            const float sc = t1 + t2;
            if (sc > bgs) { bgs = sc; bg = g; bt1 = t1; bt2 = t2; bi1 = i1; bi2 = i2; } }
        const int e0 = 8 * bg + bi1, e1 = 8 * bg + bi2; const float inv = 1.0f / (bt1 + bt2);
        const unsigned r0 = __hip_atomic_fetch_add(&lt[LT_CNT + e0], 1u, __ATOMIC_RELAXED, __HIP_MEMORY_SCOPE_WORKGROUP), r1 = __hip_atomic_fetch_add(&lt[LT_CNT + e1], 1u, __ATOMIC_RELAXED, __HIP_MEMORY_SCOPE_WORKGROUP);
        LAS unsigned* rec = lt + LT_REC + 8 * F.tid;
        rec[0] = (unsigned)(e0 | (e1 << 8)); rec[1] = r0; rec[2] = r1; rec[3] = __float_as_uint(bt1 * inv); rec[4] = __float_as_uint(bt2 * inv); rec[5] = __float_as_uint(rsl[F.tid]);
    }
    __syncthreads();
    if (F.tid < 32) lt[LT_BASE + F.tid] = __hip_atomic_fetch_add((unsigned*)(F.ws + WS_CTL) + CW_CNT + 64 * cslot + F.tid, lt[LT_CNT + F.tid], RLX_AGENT);
    __syncthreads();
    if (F.tid < 128) { const LAS unsigned* rec = lt + LT_REC + 8 * F.tid; const int tok = tokb + F.tid; const unsigned ee = rec[0]; const int e0 = ee & 255, e1 = ee >> 8;
        int* list = (int*)(F.ws + WS_LIST);
        list[e0 * NTOK + (int)(lt[LT_BASE + e0] + rec[1])] = tok; list[e1 * NTOK + (int)(lt[LT_BASE + e1] + rec[2])] = NTOK + tok;
        unsigned* rw = (unsigned*)(F.ws + WS_ROUTE + RT_W); rw[2 * tok] = rec[3]; rw[2 * tok + 1] = rec[4]; }
}
__device__ __forceinline__ void moe_tables(Frame& F, int l) {
    LAS unsigned* lt = (LAS unsigned*)(F.lds + LTAB_OFF);
    __syncthreads();
    if (F.tid < 32) lt[LT_CNT + F.tid] = __hip_atomic_load((unsigned*)(F.ws + WS_CTL) + CW_CNT + 64 * l + F.tid, RLX_AGENT);
    __syncthreads();
    if (F.tid == 0) { unsigned s = 0; for (int e = 0; e < 32; ++e) { lt[LT_SEG + e] = s; s += (lt[LT_CNT + e] + 255u) & ~255u; } lt[LT_SEG + 32] = s; }
    __syncthreads();
    if (F.tid < 32) { const unsigned t0 = lt[LT_SEG + F.tid] >> 8, t1 = lt[LT_SEG + F.tid + 1] >> 8; for (unsigned t = t0; t < t1; ++t) lt[LT_TILE + t] = (unsigned)F.tid; }
    __syncthreads();
    const int* list = (const int*)(F.ws + WS_LIST); const int ntiles = (int)(lt[LT_SEG + 32] >> 8);
    for (int idx = F.tid; idx < 5 * 256; idx += 512) { const int ord = idx >> 8, r = idx & 255, tile = (ord * F.G + F.vcu) >> 2; int v = DUMMY_ROW;
        if (tile < ntiles) { const int e = (int)lt[LT_TILE + tile], pos = 256 * (tile - (int)(lt[LT_SEG + e] >> 8)) + r; if (pos < (int)lt[LT_CNT + e]) v = list[e * NTOK + pos]; }
        lt[LT_ROW + idx] = (unsigned)v; }
    __syncthreads();
}
template <bool GATHER_> struct GroupedOrder {
    static constexpr bool GATHER = GATHER_;
    __device__ __forceinline__ unsigned arow(int ord, int row, int K) const { return (lt[LT_ROW + ord * 256 + row] & 32767u) * (unsigned)(K * 2); }
    const LAS unsigned* lt; int vcu, G, bstride;
    __device__ __forceinline__ bool next(int i, pg8::Unit& u) const {
        const int L = i * G + vcu, tile = L >> 2; if (tile >= (int)(lt[LT_SEG + 32] >> 8)) return false;
        u.pm = tile; u.pn = L & 3; u.bo = (int)lt[LT_TILE + tile] * bstride; u.ui = i; return true;
    }
    __device__ __forceinline__ void a_ready(const pg8::Unit&) const {}
    __device__ __forceinline__ void done(const pg8::Unit&) const {}
};
#ifndef DUP_PH
#define DUP_PH (-1)
#endif
#ifndef DUP_N
#define DUP_N 1
#endif
#ifndef DUP_VAR
#define DUP_VAR 0
#endif
struct Args { const float* in[23]; float* out; unsigned char* ws; int ph_lo, ph_hi; };
__global__ void __launch_bounds__(NWAVES * 64, 2) mk_fwd(Args args) {
    extern __shared__ __attribute__((aligned(16))) unsigned char lds[];
    Frame F;
    F.lds = (LAS unsigned char*)lds;
    F.tid = threadIdx.x; F.lane = F.tid & 63; F.wave = __builtin_amdgcn_readfirstlane(F.tid >> 6);
    int wave0 = F.wave; asm volatile("" : "+s"(wave0));
    F.G = gridDim.x; { const int bx = blockIdx.x; F.vcu = (F.G % 8 == 0) ? (bx % 8) * (F.G / 8) + bx / 8 : bx; }
    F.inp = (KArgPtr)__builtin_amdgcn_kernarg_segment_ptr();
    F.out = args.out; F.ws = args.ws;
    volatile LAS unsigned* MISC = (volatile LAS unsigned*)(F.lds + LDSCTL_OFF);
    for (int u = F.tid; u < (LDS_BYTES - LDSCTL_OFF) / 4; u += NWAVES * 64) MISC[u] = 0u;
    __syncthreads();
    const int lo = args.ph_lo, hi = args.ph_hi;
    XcdBarrier bar; bar.bar = (unsigned*)(F.ws + WS_CTL) + CW_BAR; bar.x = 0; bar.st = nullptr;
    if (hi - lo > 1) bar = xcd_barrier_post((unsigned*)(F.ws + WS_CTL) + CW_BAR, MISC + 8);
#ifdef P0_EXTRA
    for (int q = 0; q < P0_EXTRA; ++q) { p0_prologue(F, P0_VAR); xcd_barrier(bar, F.tid == 0); }
#endif
    for (int ph = lo; ph < hi; ++ph) {
        int w0 = wave0; unsigned ones = ~0u; asm volatile("" : "+s"(w0), "+s"(ones));
        int tid = w0 * 64 + (int)__builtin_amdgcn_mbcnt_hi(ones, __builtin_amdgcn_mbcnt_lo(ones, 0u)); asm volatile("" : "+v"(tid));
        { KArgPtr kp = (KArgPtr)__builtin_amdgcn_kernarg_segment_ptr(); asm volatile("" : "+s"(kp)); F.inp = kp; }
        F.tid = tid; F.lane = tid & 63; F.wave = __builtin_amdgcn_readfirstlane(tid >> 6);
        const int pe = (DUP_PH >= 0 && ph > DUP_PH) ? ((ph - DUP_N > DUP_PH) ? ph - DUP_N : DUP_PH) : ph;
        const int l = (pe >= 2) ? (pe - 2) / 9 : 0, kind = (pe >= 2) ? 2 + (pe - 2) % 9 : pe;
        if (kind == 0) p0_prologue(F, 0);
        else if (kind == 1) p1_first_norm(F);
        else if (kind == 2) {
            pg8::Gemm g{wsb(F, WS_HY), wsb(F, WS_WIN) + (size_t)l * PNP * DM, NTOK, PNP, DM}; pg8::StaticOrder S; S.init(NTOK, PNP, F.G, (int)blockIdx.x); S.rot = 2;
            pg8::EpiInProj E{wsb(F, WS_P), PNP, nullptr, 0.f};
            if (I8_ON(l)) { pg8::Gemm g8{h8p(F), wsb(F, WS_WIN) + (size_t)l * PNP * DM, NTOK, PNP, DM / 2}; pg8::EpiInProj Ei{wsb(F, WS_P), PNP, hsp(F), 1.0f / WI8S};
                pg8::gemm_phase<pg8::EpiInProj, pg8::StaticOrder, true, true, 0, 0, true>(F.lds, g8, S, Ei, tid); }
            else if (FP8_ON(l, 0)) { pg8::Gemm g8{h8p(F), wsb(F, WS_WIN) + (size_t)l * PNP * DM, NTOK, PNP, DM / 2}; pg8::gemm_phase<pg8::EpiInProj, pg8::StaticOrder, false, true, E8_ONE, E8_W>(F.lds, g8, S, E, tid); }
            else pg8::gemm_phase<pg8::EpiInProj, pg8::StaticOrder, true, true>(F.lds, g, S, E, tid); }
        else if (kind == 3) p3p_gla_prep(F, l);
        else if (kind == 4) p3a_gla_state(F, l, (DUP_PH >= 0 && ph >= DUP_PH && ph < DUP_PH + DUP_N) ? DUP_VAR : 0);
        else if (kind == 5) p3c_mixer_out(F, l);
        else if (kind == 6) {
            pg8::Gemm g{wsb(F, WS_HY), wsb(F, WS_WOUT) + (size_t)l * DM * DM, NTOK, DM, DM}; pg8::StaticOrder S; S.init(NTOK, DM, F.G, (int)blockIdx.x);
            const bool dry = (DUP_PH >= 0 && ph >= DUP_PH && ph < DUP_PH + DUP_N);
            pg8::EpiResid E{wsb(F, WS_X), modp(F, l) + 2048, dry ? wsb(F, WS_P) : wsb(F, WS_X)};
            if (FP8_ON(l, 1)) { pg8::Gemm g8{wsb(F, WS_HY), wsb(F, WS_WOUT) + (size_t)l * DM * DM, NTOK, DM, DM / 2}; pg8::gemm_phase<pg8::EpiResid, pg8::StaticOrder, true, true, E8_Y, E8_W>(F.lds, g8, S, E, tid); }
            else pg8::gemm_phase<pg8::EpiResid, pg8::StaticOrder, true, true>(F.lds, g, S, E, tid); }
        else if (kind == 7) p5a_route(F, l, (DUP_PH >= 0 && ph > DUP_PH && ph <= DUP_PH + DUP_N) ? l + 2 : l);
        else if (kind == 8) {
            moe_tables(F, l);
            pg8::Gemm g{wsb(F, WS_H2), wsb(F, WS_W13) + (size_t)l * NEXP * DM * DM, MAXSLOT, DM, DM};
            GroupedOrder<true> S{(const LAS unsigned*)(F.lds + LTAB_OFF), F.vcu, F.G, DM * DM};
            pg8::Gemm g8{wsb(F, WS_H2), wsb(F, WS_W13) + (size_t)l * NEXP * DM * DM, MAXSLOT, DM, DM / 2};
            pg8::EpiSwiGLU8 E8{F.ws + WS_HID, H8S}; pg8::EpiSwiGLU E{wsb(F, WS_HID)};
            if (FP8_ON(l, 2)) { if (FP8_ON(l, 3)) pg8::gemm_phase<pg8::EpiSwiGLU8, GroupedOrder<true>, true, true, E8_ONE, E8_W>(F.lds, g8, S, E8, tid);
                                else pg8::gemm_phase<pg8::EpiSwiGLU, GroupedOrder<true>, true, true, E8_ONE, E8_W>(F.lds, g8, S, E, tid); }
            else { if (FP8_ON(l, 3)) pg8::gemm_phase<pg8::EpiSwiGLU8, GroupedOrder<true>, true, true>(F.lds, g, S, E8, tid);
                   else pg8::gemm_phase<pg8::EpiSwiGLU, GroupedOrder<true>, true, true>(F.lds, g, S, E, tid); } }
        else if (kind == 9) {
            pg8::Gemm g{wsb(F, WS_HID), wsb(F, WS_W2) + (size_t)l * NEXP * DM * DFF, MAXSLOT, DM, DFF};
            GroupedOrder<false> S{(const LAS unsigned*)(F.lds + LTAB_OFF), F.vcu, F.G, DM * DFF};
#if YE_FP8
            typedef pg8::EpiScatter8 EpiY; EpiY E{F.ws + WS_YE, (const LAS int*)(F.lds + LTAB_OFF) + LT_ROW, E8S};
#else
            typedef pg8::EpiScatter EpiY; EpiY E{wsb(F, WS_YE), (const LAS int*)(F.lds + LTAB_OFF) + LT_ROW};
#endif
            if (FP8_ON(l, 3)) { pg8::Gemm g8{wsb(F, WS_HID), wsb(F, WS_W2) + (size_t)l * NEXP * DM * DFF, MAXSLOT, DM, DFF / 2};
                pg8::gemm_phase<EpiY, GroupedOrder<false>, true, true, E8_H, E8_W>(F.lds, g8, S, E, tid); }
            else pg8::gemm_phase<EpiY, GroupedOrder<false>, true, true>(F.lds, g, S, E, tid); }
        else p9_combine(F, l, (DUP_PH >= 0 && ph >= DUP_PH && ph < DUP_PH + DUP_N));
        if (ph + 1 < hi) xcd_barrier(bar, tid == 0);
    }
}

extern "C" void kernel_launch(void* const* d_in, const int* in_sizes, int n_in, void* d_out, int out_size, void* d_ws, size_t ws_size, hipStream_t stream) {
    static int grid = 0;
    if (grid == 0) {
        if (n_in != 23 || in_sizes[0] != NTOK * DM || out_size != NTOK * DM || ws_size < WS_END) {
            fprintf(stderr, "kernel_launch: unexpected problem (n_in %d, in0 %d, out %d, ws %zu; need ws >= %zu); nothing launched\n", n_in, n_in > 0 ? in_sizes[0] : -1, out_size, ws_size, (size_t)WS_END); grid = -1; return; }
        int dev = 0, cus = 0, per_cu = 0;
        if (hipGetDevice(&dev) != hipSuccess || hipDeviceGetAttribute(&cus, hipDeviceAttributeMultiprocessorCount, dev) != hipSuccess) { grid = -1; return; }
        if (hipFuncSetAttribute((const void*)mk_fwd, hipFuncAttributeMaxDynamicSharedMemorySize, LDS_BYTES) != hipSuccess) { fprintf(stderr, "kernel_launch: hipFuncSetAttribute failed\n"); grid = -1; return; }
        if (hipOccupancyMaxActiveBlocksPerMultiprocessor(&per_cu, (const void*)mk_fwd, NWAVES * 64, LDS_BYTES) != hipSuccess || per_cu < 1)
            fprintf(stderr, "kernel_launch: note: occupancy query reports %d workgroups per CU\n", per_cu);
        (void)hipGetLastError();
        grid = cus;
        if (grid != 256) fprintf(stderr, "kernel_launch: %d CUs; the phase bodies assume 256 workgroups\n", grid);
    }
    if (grid < 0) return;
    if (hipMemsetAsync((char*)d_ws + WS_CTL, 0, CTL_ZERO_BYTES, stream) != hipSuccess) { fprintf(stderr, "kernel_launch: memset failed\n"); return; }
    Args a{};
    for (int i = 0; i < 23; ++i) a.in[i] = (const float*)d_in[i];
    a.out = (float*)d_out; a.ws = (unsigned char*)d_ws;
    if (MK_N_LAUNCHES == 1) { a.ph_lo = 0; a.ph_hi = NPHASES + (DUP_PH >= 0 ? DUP_N : 0); hipLaunchKernelGGL(mk_fwd, dim3(grid), dim3(NWAVES * 64), LDS_BYTES, stream, a); }
    else for (int p = 0; p < NPHASES; ++p) { a.ph_lo = p; a.ph_hi = p + 1; hipLaunchKernelGGL(mk_fwd, dim3(grid), dim3(NWAVES * 64), LDS_BYTES, stream, a); }
    const hipError_t le = hipPeekAtLastError();
    if (le != hipSuccess) fprintf(stderr, "kernel_launch: launch failed: %s\n", hipGetErrorName(le));
}
```

```cpp
#include <hip/hip_runtime.h>
#include <cstdio>
#include <cstdint>
namespace pg8 {
#define PG8_LAS __attribute__((address_space(3)))
typedef unsigned short bf16_t;
typedef short bf16x8 __attribute__((ext_vector_type(8)));
typedef float f32x4 __attribute__((ext_vector_type(4)));
typedef unsigned u32x4 __attribute__((ext_vector_type(4)));
typedef int pg8_v4i __attribute__((ext_vector_type(4)));
typedef int pg8_v8i __attribute__((ext_vector_type(8)));
constexpr int BM = 256, BK = 64, HALF = 128, HTB = HALF * BK * 2  , STAGE_BYTES = 8 * HTB, NXCD = 8, WGM = 8;

__host__ __device__ __forceinline__ int lds_byte(int r, int c) { const int st = (r >> 4) * 2 + (c >> 5), rr = r & 15, cc = c & 31, ob = rr * 64 + cc * 2; return st * 1024 + (ob ^ (((ob >> 9) & 1) << 5)); }
__host__ __device__ __forceinline__ void stage_rc(int b, int& R, int& C) { const int st = b / 1024, sb = b % 1024, swz = sb ^ (((sb >> 9) & 1) << 5); R = (st >> 1) * 16 + swz / 64; C = (st & 1) * 32 + (swz % 64) / 2; }
__host__ __device__ __forceinline__ int perm32(int rho) { const int n = rho >> 4, i = rho & 15; return 8 * (i >> 2) + 4 * n + (i & 3); }

struct Unit { int pm, pn, bo, ui; };
struct Gemm { const bf16_t* A; const bf16_t* Bt; int M, N, K; };

struct StaticOrder {
    static constexpr bool GATHER = false;
    __device__ __forceinline__ unsigned arow(int, int, int) const { return 0u; }
    int nM, nN, nwg, G, c, rot = 0;
    __host__ __device__ void init(int M, int N, int G_, int c_) { nM = M / BM; nN = N / BM; nwg = nM * nN; G = G_; c = c_; }
    __host__ __device__ bool next(int i, Unit& u) const {
        const long L = (long)i * G + c; if (L >= nwg) return false;
        int wgid = (int)L; { const int q = nwg / NXCD, r = nwg % NXCD, xcd = wgid % NXCD, off = wgid / NXCD; wgid = (xcd < r ? xcd * (q + 1) : r * (q + 1) + (xcd - r) * q) + off; }
        const int nig = WGM * nN, gid = wgid / nig, fm = gid * WGM, gsz = (nM - fm) < WGM ? (nM - fm) : WGM;
        u.pm = fm + ((wgid % nig) % gsz); u.pn = (wgid % nig) / gsz; u.bo = 0; u.ui = i; return true;
    }
    __device__ __forceinline__ void a_ready(const Unit&) const {}
    __device__ __forceinline__ void done(const Unit&) const {}
};

__device__ __forceinline__ unsigned cvt_pk_bf16(float lo, float hi) { unsigned r; asm volatile("v_cvt_pk_bf16_f32 %0, %1, %2" : "=v"(r) : "v"(lo), "v"(hi)); return r; }
typedef float f32x2 __attribute__((ext_vector_type(2)));
__device__ __forceinline__ f32x2 gelu_pk(f32x2 v) {
    const f32x2 av = __builtin_elementwise_abs(v), d = av * 0.2316418882f + 1.0f;
    f32x2 t; t.x = __builtin_amdgcn_rcpf(d.x); t.y = __builtin_amdgcn_rcpf(d.y);
    f32x2 q = t * 0.5307027145f + (-0.7265760135f); q = q * t + 0.7107068705f; q = q * t + (-0.142248368f); q = q * t + 0.127414796f; q = q * t;
    const f32x2 s = (v * v) * (-0.72134752044f);
    f32x2 e; e.x = __builtin_amdgcn_exp2f(s.x); e.y = __builtin_amdgcn_exp2f(s.y);
    const f32x2 m = v * (q * e), r = v - m;
    f32x2 o; o.x = v.x < 0.f ? m.x : r.x; o.y = v.y < 0.f ? m.y : r.y; return o;
}

__device__ __forceinline__ float bf_lo(unsigned w) { return __uint_as_float(w << 16); }
__device__ __forceinline__ float bf_hi(unsigned w) { return __uint_as_float(w & 0xffff0000u); }
__device__ __forceinline__ float silu_f(float a) { return a * __builtin_amdgcn_rcpf(1.0f + __expf(-a)); }

struct EpiInProj {
    static constexpr bool PERM = true, AFTER_DRAIN = false;
    static constexpr int NVM = 16;
    static constexpr bool ALWAYS_FULL = false;
    __device__ __forceinline__ bool full(const Unit& u) const { return u.pn != 11; }
    bf16_t* O; int ldc; const float* rs; float ws;
    __device__ __forceinline__ void operator()(const f32x4 (&acc)[2][2][4][2], const Unit& u, int wr, int wc, int fr, int fq) const {
        asm volatile("" : "+v"(fr), "+v"(fq));
        const int row0 = u.pm * BM + wr * 64 + fr, col0 = u.pn * BM + wc * 32 + 8 * fq;
        const bool act = u.pn < 2, last_tile = u.pn == 11;
        float dqv[8];
#pragma unroll
        for (int q = 0; q < 8; ++q) dqv[q] = rs ? rs[row0 + (q >> 2) * HALF + (q & 3) * 16] * ws : 0.f;
#pragma unroll
        for (int ai = 0; ai < 2; ++ai)
#pragma unroll
            for (int m = 0; m < 4; ++m) { bf16_t* rowp = O + (size_t)(row0 + ai * HALF + m * 16) * ldc + col0; const float dq = dqv[ai * 4 + m];
#pragma unroll
                for (int bj = 0; bj < 2; ++bj) { f32x4 v0 = acc[ai][bj][m][0], v1 = acc[ai][bj][m][1];
                    if (rs) { const pg8_v4i i0 = __builtin_bit_cast(pg8_v4i, v0), i1 = __builtin_bit_cast(pg8_v4i, v1);
                        v0 = (f32x4){(float)i0[0], (float)i0[1], (float)i0[2], (float)i0[3]} * dq; v1 = (f32x4){(float)i1[0], (float)i1[1], (float)i1[2], (float)i1[3]} * dq; }
                    if (last_tile && (bj != 0 || wc != 0 || fq >= 2)) continue;
                    if (act) { f32x2 a = gelu_pk((f32x2){v0[0], v0[1]}), b = gelu_pk((f32x2){v0[2], v0[3]}), c = gelu_pk((f32x2){v1[0], v1[1]}), d = gelu_pk((f32x2){v1[2], v1[3]});
                        v0 = (f32x4){a.x, a.y, b.x, b.y}; v1 = (f32x4){c.x, c.y, d.x, d.y}; }
                    u32x4 w; w.x = cvt_pk_bf16(v0[0], v0[1]); w.y = cvt_pk_bf16(v0[2], v0[3]); w.z = cvt_pk_bf16(v1[0], v1[1]); w.w = cvt_pk_bf16(v1[2], v1[3]);
                    *(u32x4*)(rowp + bj * HALF) = w; } }
    }
};

struct EpiResid {
    static constexpr bool PERM = true, AFTER_DRAIN = false;
    static constexpr int NVM = 32;
    static constexpr bool ALWAYS_FULL = true;
    __device__ __forceinline__ bool full(const Unit& u) const { return true; }
    bf16_t* X; const float* gt; bf16_t* Xo;
    __device__ __forceinline__ void operator()(const f32x4 (&acc)[2][2][4][2], const Unit& u, int wr, int wc, int fr, int fq) const {
        asm volatile("" : "+v"(fr), "+v"(fq));
        const int row0 = u.pm * BM + wr * 64 + fr, col0 = u.pn * BM + wc * 32 + 8 * fq;
        const float* gp = gt + (size_t)(u.pm >> 3) * 6144 + col0;
#pragma unroll
        for (int bj = 0; bj < 2; ++bj) { const f32x4 g0 = *(const f32x4*)(gp + bj * HALF), g1 = *(const f32x4*)(gp + bj * HALF + 4);
        u32x4 xq[8];
#pragma unroll
        for (int q = 0; q < 8; ++q) xq[q] = *(const u32x4*)(X + (size_t)(row0 + (q >> 2) * HALF + (q & 3) * 16) * 1024 + col0 + bj * HALF);
        asm volatile("" ::: "memory");
#pragma unroll
        for (int ai = 0; ai < 2; ++ai)
#pragma unroll
            for (int m = 0; m < 4; ++m) { bf16_t* rowp = X + (size_t)(row0 + ai * HALF + m * 16) * 1024 + col0;
                const u32x4 xv = xq[ai * 4 + m];
                const f32x4 a0 = acc[ai][bj][m][0], a1 = acc[ai][bj][m][1];
                u32x4 w;
                w.x = cvt_pk_bf16(bf_lo(xv.x) + g0[0] * a0[0], bf_hi(xv.x) + g0[1] * a0[1]);
                w.y = cvt_pk_bf16(bf_lo(xv.y) + g0[2] * a0[2], bf_hi(xv.y) + g0[3] * a0[3]);
                w.z = cvt_pk_bf16(bf_lo(xv.z) + g1[0] * a1[0], bf_hi(xv.z) + g1[1] * a1[1]);
                w.w = cvt_pk_bf16(bf_lo(xv.w) + g1[2] * a1[2], bf_hi(xv.w) + g1[3] * a1[3]);
                *(u32x4*)(Xo + (rowp - X) + bj * HALF) = w; } }
    }
};

struct EpiSwiGLU {
    static constexpr bool PERM = true, AFTER_DRAIN = false;
    static constexpr int NVM = 8;
    static constexpr bool ALWAYS_FULL = true;
    __device__ __forceinline__ bool full(const Unit& u) const { return true; }
    bf16_t* O;
    __device__ __forceinline__ void operator()(const f32x4 (&acc)[2][2][4][2], const Unit& u, int wr, int wc, int fr, int fq) const {
        asm volatile("" : "+v"(fr), "+v"(fq));
        const int row0 = u.pm * BM + wr * 64 + fr, col0 = u.pn * HALF + wc * 32 + 8 * fq;
#pragma unroll
        for (int ai = 0; ai < 2; ++ai)
#pragma unroll
            for (int m = 0; m < 4; ++m) { bf16_t* rowp = O + (size_t)(row0 + ai * HALF + m * 16) * 512 + col0;
                const f32x4 a0 = acc[ai][0][m][0], a1 = acc[ai][0][m][1], b0 = acc[ai][1][m][0], b1 = acc[ai][1][m][1];
                u32x4 w;
                w.x = cvt_pk_bf16(silu_f(a0[0]) * b0[0], silu_f(a0[1]) * b0[1]); w.y = cvt_pk_bf16(silu_f(a0[2]) * b0[2], silu_f(a0[3]) * b0[3]);
                w.z = cvt_pk_bf16(silu_f(a1[0]) * b1[0], silu_f(a1[1]) * b1[1]); w.w = cvt_pk_bf16(silu_f(a1[2]) * b1[2], silu_f(a1[3]) * b1[3]);
                *(u32x4*)rowp = w; }
    }
};

__device__ __forceinline__ unsigned pk4_fp8(float a, float b, float c, float d) {
    a = __builtin_amdgcn_fmed3f(a, -448.f, 448.f); b = __builtin_amdgcn_fmed3f(b, -448.f, 448.f); c = __builtin_amdgcn_fmed3f(c, -448.f, 448.f); d = __builtin_amdgcn_fmed3f(d, -448.f, 448.f);
    unsigned w = 0u; w = (unsigned)__builtin_amdgcn_cvt_pk_fp8_f32(a, b, (int)w, false); w = (unsigned)__builtin_amdgcn_cvt_pk_fp8_f32(c, d, (int)w, true); return w;
}
struct EpiSwiGLU8 {
    static constexpr bool PERM = true, AFTER_DRAIN = false;
    static constexpr int NVM = 8;
    static constexpr bool ALWAYS_FULL = true;
    __device__ __forceinline__ bool full(const Unit& u) const { return true; }
    unsigned char* O; float SC;
    __device__ __forceinline__ void operator()(const f32x4 (&acc)[2][2][4][2], const Unit& u, int wr, int wc, int fr, int fq) const {
        asm volatile("" : "+v"(fr), "+v"(fq));
        const int row0 = u.pm * BM + wr * 64 + fr, col0 = u.pn * HALF + wc * 32 + 8 * fq;
#pragma unroll
        for (int ai = 0; ai < 2; ++ai)
#pragma unroll
            for (int m = 0; m < 4; ++m) { unsigned char* rowp = O + (size_t)(row0 + ai * HALF + m * 16) * 512 + col0;
                const f32x4 a0 = acc[ai][0][m][0], a1 = acc[ai][0][m][1], b0 = acc[ai][1][m][0] * SC, b1 = acc[ai][1][m][1] * SC;
                typedef unsigned u32x2 __attribute__((ext_vector_type(2)));
                u32x2 w; w.x = pk4_fp8(silu_f(a0[0]) * b0[0], silu_f(a0[1]) * b0[1], silu_f(a0[2]) * b0[2], silu_f(a0[3]) * b0[3]);
                w.y = pk4_fp8(silu_f(a1[0]) * b1[0], silu_f(a1[1]) * b1[1], silu_f(a1[2]) * b1[2], silu_f(a1[3]) * b1[3]);
                *(u32x2*)rowp = w; }
    }
};

struct EpiScatter8 {
    static constexpr bool PERM = true, AFTER_DRAIN = false;
    static constexpr int NVM = 16;
    static constexpr bool ALWAYS_FULL = true;
    __device__ __forceinline__ bool full(const Unit& u) const { return true; }
    unsigned char* O; const PG8_LAS int* rowtab; float SC;
    __device__ __forceinline__ void operator()(const f32x4 (&acc)[2][2][4][2], const Unit& u, int wr, int wc, int fr, int fq) const {
        asm volatile("" : "+v"(fr), "+v"(fq));
        const int col0 = u.pn * BM + wc * 32 + 8 * fq;
        typedef unsigned u32x2 __attribute__((ext_vector_type(2)));
#pragma unroll
        for (int ai = 0; ai < 2; ++ai)
#pragma unroll
            for (int m = 0; m < 4; ++m) { const int d = rowtab[u.ui * BM + wr * 64 + fr + ai * HALF + m * 16]; unsigned char* rowp = O + (size_t)d * 1024 + col0;
#pragma unroll
                for (int bj = 0; bj < 2; ++bj) { const f32x4 v0 = acc[ai][bj][m][0] * SC, v1 = acc[ai][bj][m][1] * SC;
                    *(u32x2*)(rowp + bj * HALF) = (u32x2){pk4_fp8(v0[0], v0[1], v0[2], v0[3]), pk4_fp8(v1[0], v1[1], v1[2], v1[3])}; } }
    }
};

struct EpiScatter {
    static constexpr bool PERM = true, AFTER_DRAIN = false;
    static constexpr int NVM = 16;
    static constexpr bool ALWAYS_FULL = true;
    __device__ __forceinline__ bool full(const Unit& u) const { return true; }
    bf16_t* O; const PG8_LAS int* rowtab;
    __device__ __forceinline__ void operator()(const f32x4 (&acc)[2][2][4][2], const Unit& u, int wr, int wc, int fr, int fq) const {
        asm volatile("" : "+v"(fr), "+v"(fq));
        const int row0 = u.pm * BM + wr * 64 + fr, col0 = u.pn * BM + wc * 32 + 8 * fq;
#pragma unroll
        for (int ai = 0; ai < 2; ++ai)
#pragma unroll
            for (int m = 0; m < 4; ++m) { const int d = rowtab[u.ui * BM + wr * 64 + fr + ai * HALF + m * 16]; bf16_t* rowp = O + (size_t)d * 1024 + col0;
#pragma unroll
                for (int bj = 0; bj < 2; ++bj) { const f32x4 v0 = acc[ai][bj][m][0], v1 = acc[ai][bj][m][1];
                    u32x4 w; w.x = cvt_pk_bf16(v0[0], v0[1]); w.y = cvt_pk_bf16(v0[2], v0[3]); w.z = cvt_pk_bf16(v1[0], v1[1]); w.w = cvt_pk_bf16(v1[2], v1[3]);
                    *(u32x4*)(rowp + bj * HALF) = w; } }
    }
};

template <class Epi, class Sched, bool ALIGN_EPI = false, bool SP2 = false, int FP8SA = 0, int FP8SB = 0, bool I8 = false>
__device__ __forceinline__ void gemm_phase(PG8_LAS unsigned char* lds, const Gemm g, const Sched& S, const Epi& E, const int tid) {
    const int wid = __builtin_amdgcn_readfirstlane(tid >> 6), lane = tid & 63, wr = wid >> 2, wc = wid & 3, fr = lane & 15, fq = lane >> 4;
    const int K = g.K, nt = K / BK;
    unsigned voffA[2], voffB[2];
    unsigned ga[2][2], gn[2][2];
#pragma unroll
    for (int i = 0; i < 2; ++i) { int R, C; stage_rc(tid * 16 + i * 8192, R, C); const int Rb = Epi::PERM ? ((R & ~31) + perm32(R & 31)) : R;
        voffA[i] = (unsigned)(R * K + C) * 2u; voffB[i] = (unsigned)(Rb * K + C) * 2u; }
    const size_t kstep = (size_t)(BK * 2);
    const size_t hstep = (size_t)HALF * K * 2;
    const size_t tstep = 2 * hstep;
    const unsigned ldsw = (unsigned)wid * 1024u;
    const int aoff = lds_byte(wr * 64 + fr, fq * 8), boff = lds_byte(wc * 32 + fr, fq * 8);
#define PG8_SA(b, h) (((b) * 2 + (h)) * HTB)
#define PG8_SB(b, h) ((4 + (b) * 2 + (h)) * HTB)
#define PG8_STAGE(bufoff, gbase, voff) do { _Pragma("unroll") for (int _i = 0; _i < 2; ++_i) \
        __builtin_amdgcn_global_load_lds((const unsigned*)((const char*)(gbase) + (voff)[_i]), (PG8_LAS unsigned*)(lds + (bufoff) + ldsw + _i * 8192), 16, 0, 0); } while (0)
#define PG8_STAGE_A(bufoff, ptr, h, nx, kb) do { if constexpr (Sched::GATHER) { _Pragma("unroll") for (int _i = 0; _i < 2; ++_i) { const unsigned _o = ((nx) ? gn[h][_i] : ga[h][_i]) + (unsigned)(kb); \
        __builtin_amdgcn_global_load_lds((const unsigned*)((const char*)g.A + _o), (PG8_LAS unsigned*)(lds + (bufoff) + ldsw + _i * 8192), 16, 0, 0); } } else { PG8_STAGE(bufoff, ptr, voffA); } } while (0)
#define PG8_GOFF(dst, ord) do { if constexpr (Sched::GATHER) { _Pragma("unroll") for (int _i = 0; _i < 2; ++_i) { int _R, _C; stage_rc(tid * 16 + _i * 8192, _R, _C);   \
        _Pragma("unroll") for (int _h = 0; _h < 2; ++_h) dst[_h][_i] = S.arow((ord), 128 * _h + _R, K) + (unsigned)_C * 2u; } } } while (0)
#define PG8_LD8(p) __builtin_shufflevector(*(const PG8_LAS pg8_v4i*)(p), *(const PG8_LAS pg8_v4i*)((p) + 1024), 0, 1, 2, 3, 4, 5, 6, 7)
#define PG8_LDA(dst, b, h) do { if constexpr (FP8SA != 0) { _Pragma("unroll") for (int m = 0; m < 4; ++m) dst##8[m] = PG8_LD8(lds + PG8_SA(b, h) + aoff + m * 2048); } \
        else { _Pragma("unroll") for (int m = 0; m < 4; ++m) _Pragma("unroll") for (int k = 0; k < 2; ++k) dst[m][k] = *(const PG8_LAS bf16x8*)(lds + PG8_SA(b, h) + aoff + m * 2048 + k * 1024); } } while (0)
#define PG8_LDB(dst, b, h) do { if constexpr (FP8SA != 0) { _Pragma("unroll") for (int n = 0; n < 2; ++n) dst##8[n] = PG8_LD8(lds + PG8_SB(b, h) + boff + n * 2048); } \
        else { _Pragma("unroll") for (int n = 0; n < 2; ++n) _Pragma("unroll") for (int k = 0; k < 2; ++k) dst[n][k] = *(const PG8_LAS bf16x8*)(lds + PG8_SB(b, h) + boff + n * 2048 + k * 1024); } } while (0)
#define PG8_MMA(ai, bj, At, Bt) do { __builtin_amdgcn_s_setprio(1); _Pragma("unroll") for (int m = 0; m < 4; ++m) _Pragma("unroll") for (int n = 0; n < 2; ++n) { \
        if constexpr (FP8SA != 0) asm volatile("v_mfma_scale_f32_16x16x128_f8f6f4 %0, %1, %2, %0, %3, %4 op_sel_hi:[0,0,0]" : "+v"(acc[ai][bj][m][n]) : "v"(Bt##8[n]), "v"(At##8[m]), "v"(sc8b), "v"(sc8a));   \
        else if constexpr (I8) { _Pragma("unroll") for (int k = 0; k < 2; ++k) acc[ai][bj][m][n] = __builtin_bit_cast(f32x4, __builtin_amdgcn_mfma_i32_16x16x64_i8(__builtin_bit_cast(pg8_v4i, Bt[n][k]), __builtin_bit_cast(pg8_v4i, At[m][k]), __builtin_bit_cast(pg8_v4i, acc[ai][bj][m][n]), 0, 0, 0)); } \
        else { _Pragma("unroll") for (int k = 0; k < 2; ++k) acc[ai][bj][m][n] = __builtin_amdgcn_mfma_f32_16x16x32_bf16(Bt[n][k], At[m][k], acc[ai][bj][m][n], 0, 0, 0); } } __builtin_amdgcn_s_setprio(0); } while (0)
#define PG8_WAIT_V(n) asm volatile("s_waitcnt vmcnt(" #n ")" ::: "memory")
#define PG8_WAIT_VN(n) asm volatile("s_waitcnt vmcnt(%0)" :: "n"(n) : "memory")
#define PG8_WAIT_VR(rl) do { if (rl) PG8_WAIT_VN(8 + Epi::NVM); else PG8_WAIT_V(8); } while (0)
#define PG8_WAIT_L(n) asm volatile("s_waitcnt lgkmcnt(" #n ")" ::: "memory")
#define PG8_BAR __builtin_amdgcn_s_barrier()
#define PG8_SCHED __builtin_amdgcn_sched_barrier(0)
    Unit cur, nxt; int ui = 0;
    if (!S.next(0, cur)) return;
    f32x4 acc[2][2][4][2];
#pragma unroll
    for (int a = 0; a < 2; ++a)
#pragma unroll
        for (int b = 0; b < 2; ++b)
#pragma unroll
            for (int m = 0; m < 4; ++m)
#pragma unroll
                for (int n = 0; n < 2; ++n) acc[a][b][m][n] = (f32x4){0.f, 0.f, 0.f, 0.f};
    bf16x8 At[4][2], B0[2][2], B1[2][2];
    pg8_v8i At8[4], B08[2], B18[2];
    const int sc8a = FP8SA * 0x01010101, sc8b = FP8SB * 0x01010101;
    const char* cA = (const char*)g.A + (size_t)cur.pm * tstep; const char* cB = (const char*)g.Bt + (size_t)cur.bo * 2 + (size_t)cur.pn * tstep;
    S.a_ready(cur);
    PG8_GOFF(ga, 0); PG8_GOFF(gn, 0);
    if constexpr (SP2) {
        PG8_STAGE(PG8_SB(0, 0), cB, voffB); PG8_STAGE(PG8_SB(0, 1), cB + hstep, voffB); PG8_STAGE_A(PG8_SA(0, 0), cA, 0, false, 0); PG8_STAGE_A(PG8_SA(0, 1), cA + hstep, 1, false, 0);
        if (wr == 1) PG8_BAR;
        PG8_WAIT_V(2); PG8_BAR;
        PG8_STAGE(PG8_SB(1, 0), cB + kstep, voffB); PG8_STAGE_A(PG8_SA(1, 0), cA + kstep, 0, false, kstep); PG8_STAGE(PG8_SB(1, 1), cB + hstep + kstep, voffB);
        PG8_WAIT_V(6); PG8_BAR;
    } else {
        PG8_STAGE(PG8_SB(0, 0), cB, voffB); PG8_STAGE(PG8_SA(0, 0), cA, voffA); PG8_STAGE(PG8_SB(0, 1), cB + hstep, voffB); PG8_STAGE(PG8_SA(0, 1), cA + hstep, voffA);
        if (wr == 1) PG8_BAR;
        PG8_WAIT_V(4); PG8_BAR;
        PG8_STAGE(PG8_SB(1, 0), cB + kstep, voffB); PG8_STAGE(PG8_SA(1, 0), cA + kstep, voffA); PG8_STAGE(PG8_SB(1, 1), cB + hstep + kstep, voffB);
        PG8_WAIT_V(6); PG8_BAR;
    }
    bool relax = false;
    for (;;) {
        const bool has_next = S.next(ui + 1, nxt);
        if constexpr (Sched::GATHER) { if (has_next) PG8_GOFF(gn, ui + 1); else { _Pragma("unroll") for (int _h = 0; _h < 2; ++_h) _Pragma("unroll") for (int _i = 0; _i < 2; ++_i) gn[_h][_i] = ga[_h][_i]; } }
        const char* nA = has_next ? (const char*)g.A + (size_t)nxt.pm * tstep : cA; const char* nB = has_next ? (const char*)g.Bt + (size_t)nxt.bo * 2 + (size_t)nxt.pn * tstep : cB;
#pragma nounroll
        for (int t = 0; t < nt; t += 2) {
            const bool last = (t == nt - 2);
            const char* a1 = cA + (size_t)(t + 1) * kstep;
            const char* a2 = last ? nA : cA + (size_t)(t + 2) * kstep; const char* b2 = last ? nB : cB + (size_t)(t + 2) * kstep;
            const char* a3 = a2 + kstep; const char* b3 = b2 + kstep;
            const size_t kb1 = (size_t)(t + 1) * kstep, kb2 = last ? 0 : (size_t)(t + 2) * kstep, kb3 = kb2 + kstep;
            if (last && has_next) S.a_ready(nxt);
            if constexpr (SP2) {
            const bool rl = Epi::ALWAYS_FULL ? (ui > 0 && t == 0) : (relax && t == 0);
            PG8_LDB(B0, 0, 0); PG8_LDB(B1, 0, 1); PG8_SCHED; PG8_LDA(At, 0, 0); if (!rl) PG8_STAGE_A(PG8_SA(1, 1), a1 + hstep, 1, false, kb1);
            PG8_WAIT_VR(rl); PG8_WAIT_L(0); PG8_BAR; PG8_MMA(0, 0, At, B0); PG8_MMA(0, 1, At, B1); PG8_BAR; PG8_SCHED;
            PG8_LDA(At, 0, 1); PG8_STAGE(PG8_SB(0, 0), b2, voffB); PG8_STAGE(PG8_SB(0, 1), b2 + hstep, voffB); PG8_STAGE_A(PG8_SA(0, 0), a2, 0, last, kb2);
            PG8_WAIT_VR(rl); PG8_WAIT_L(0); PG8_BAR; PG8_MMA(1, 0, At, B0); PG8_MMA(1, 1, At, B1); PG8_BAR; PG8_SCHED;
            PG8_LDB(B0, 1, 0); PG8_LDB(B1, 1, 1); PG8_SCHED; PG8_LDA(At, 1, 0); PG8_STAGE_A(PG8_SA(0, 1), a2 + hstep, 1, last, kb2);
            PG8_WAIT_VR(rl); PG8_WAIT_L(0); PG8_BAR; PG8_MMA(0, 0, At, B0); PG8_MMA(0, 1, At, B1); PG8_BAR; PG8_SCHED;
            PG8_LDA(At, 1, 1); PG8_STAGE(PG8_SB(1, 0), b3, voffB); PG8_STAGE(PG8_SB(1, 1), b3 + hstep, voffB); PG8_STAGE_A(PG8_SA(1, 0), a3, 0, last, kb3);
            PG8_WAIT_V(8); PG8_WAIT_L(0); PG8_BAR; PG8_MMA(1, 0, At, B0); PG8_MMA(1, 1, At, B1); PG8_BAR; PG8_SCHED;
            } else {
            PG8_LDB(B0, 0, 0); PG8_SCHED; PG8_LDA(At, 0, 0); PG8_STAGE(PG8_SA(1, 1), a1 + hstep, voffA);
            PG8_WAIT_L(8); PG8_BAR; PG8_WAIT_L(0); PG8_MMA(0, 0, At, B0); PG8_BAR; PG8_SCHED;
            PG8_LDB(B1, 0, 1); PG8_STAGE(PG8_SB(0, 0), b2, voffB);
            PG8_BAR; PG8_WAIT_L(0); PG8_MMA(0, 1, At, B1); PG8_BAR;
            PG8_LDA(At, 0, 1); PG8_STAGE(PG8_SA(0, 0), a2, voffA);
            PG8_BAR; PG8_WAIT_L(0); PG8_MMA(1, 0, At, B0); PG8_BAR; PG8_SCHED;
            PG8_STAGE(PG8_SB(0, 1), b2 + hstep, voffB);
            PG8_WAIT_V(6); PG8_BAR; PG8_MMA(1, 1, At, B1); PG8_BAR;
            PG8_LDB(B0, 1, 0); PG8_SCHED; PG8_LDA(At, 1, 0); PG8_STAGE(PG8_SA(0, 1), a2 + hstep, voffA);
            PG8_WAIT_L(8); PG8_BAR; PG8_WAIT_L(0); PG8_MMA(0, 0, At, B0); PG8_BAR; PG8_SCHED;
            PG8_LDB(B1, 1, 1); PG8_STAGE(PG8_SB(1, 0), b3, voffB);
            PG8_BAR; PG8_WAIT_L(0); PG8_MMA(0, 1, At, B1); PG8_BAR;
            PG8_LDA(At, 1, 1); PG8_STAGE(PG8_SA(1, 0), a3, voffA);
            PG8_BAR; PG8_WAIT_L(0); PG8_MMA(1, 0, At, B0); PG8_BAR; PG8_SCHED;
            PG8_STAGE(PG8_SB(1, 1), b3 + hstep, voffB);
            PG8_WAIT_V(6); PG8_BAR; PG8_MMA(1, 1, At, B1); PG8_BAR;
            }
        }
        if constexpr (ALIGN_EPI) { if (wr == 0) PG8_BAR; }
        if constexpr (ALIGN_EPI && SP2) {
            relax = has_next && (Epi::ALWAYS_FULL || E.full(cur));
            if (relax) PG8_STAGE_A(PG8_SA(1, 1), nA + kstep + hstep, 1, true, kstep);
            asm volatile("" ::: "memory");
        }
        if constexpr (FP8SA != 0) asm volatile("s_nop 15\n\ts_nop 15" ::: "memory");
        if constexpr (!Epi::AFTER_DRAIN) { E(acc, cur, wr, wc, fr, fq); S.done(cur); }
        if (!has_next) break;
#pragma unroll
        for (int a = 0; a < 2; ++a)
#pragma unroll
            for (int b = 0; b < 2; ++b)
#pragma unroll
                for (int m = 0; m < 4; ++m)
#pragma unroll
                    for (int n = 0; n < 2; ++n) acc[a][b][m][n] = (f32x4){0.f, 0.f, 0.f, 0.f};
        cur = nxt; cA = nA; cB = nB; ++ui;
        if constexpr (Sched::GATHER) { _Pragma("unroll") for (int _h = 0; _h < 2; ++_h) _Pragma("unroll") for (int _i = 0; _i < 2; ++_i) ga[_h][_i] = gn[_h][_i]; }
        if constexpr (ALIGN_EPI) { if (wr == 1) PG8_BAR; }
    }
    PG8_WAIT_V(0);
    if constexpr (!ALIGN_EPI) { if (wr == 0) PG8_BAR; }
    PG8_BAR;
    if constexpr (Epi::AFTER_DRAIN) { E.fused(acc, cur, wr, wc, fr, fq, lds, wid, lane); S.done(cur); }
#undef PG8_SA
#undef PG8_SB
#undef PG8_STAGE
#undef PG8_STAGE_A
#undef PG8_GOFF
#undef PG8_LDA
#undef PG8_LDB
#undef PG8_MMA
#undef PG8_LD8
#undef PG8_WAIT_V
#undef PG8_WAIT_L
#undef PG8_BAR
#undef PG8_SCHED
}
}
#ifndef MK_N_LAUNCHES
#define MK_N_LAUNCHES 1
#endif
constexpr int NPHASES = 20;

constexpr int NTOK = 32768, DM = 1024, SEQ = 2048, NBATCH = 16, NLAYER = 2;
constexpr int PIN = 2832, PNP = 3072;
constexpr int PC_U = 0, PC_VV = 256, PC_Q = 512, PC_K = 768, PC_V = 1024, PC_OG = 1536, PC_CB = 2048, PC_CC = 2304, PC_CX = 2560, PC_G = 2816;
constexpr int NEXP = 32, DFF = 512;
constexpr int MAXSLOT = 73728;
constexpr int DUMMY_ROW = 65536;
constexpr float EPS = 1e-6f;

constexpr size_t MiB = 1u << 20;
constexpr size_t WS_CTL = 0, CTL_ZERO_BYTES = 131072;
constexpr size_t WS_WIN = 2 * MiB;
constexpr size_t WS_WOUT = 14 * MiB;
constexpr size_t WS_W13 = 18 * MiB;
constexpr size_t WS_W2 = 146 * MiB;
constexpr size_t WS_GW = 210 * MiB;
constexpr size_t WS_WR = 210 * MiB + 524288;
constexpr size_t WS_WG = 210 * MiB + 655360;
constexpr size_t WS_ROUTE = 211 * MiB;
constexpr size_t WS_X = 214 * MiB;
constexpr size_t WS_HY = 278 * MiB;
constexpr size_t WS_P = 342 * MiB;
constexpr size_t WS_H2 = 278 * MiB;
constexpr size_t WS_HID = 422 * MiB;
constexpr size_t WS_YE = 278 * MiB;
constexpr size_t WS_LIST = 534 * MiB;
constexpr size_t WS_END = 538 * MiB;
static_assert(WS_HID + (size_t)MAXSLOT * 512 * 2 <= WS_LIST && WS_YE + (size_t)65537 * 2048 <= WS_HID, "ws map");
constexpr size_t RT_E = 0;
constexpr size_t RT_POS = 131072;
constexpr size_t RT_W = 393216;
constexpr size_t RT_RSTD = 655360;
constexpr size_t RT_DST = 786432;
constexpr size_t RT_DEC = 1081344;
static_assert(RT_DEC + 2048 * 64 * 4 <= 3 * MiB, "route region");
constexpr int CW_BAR = 4096;
constexpr int CW_CNT = 16384;
constexpr size_t CTL_MOD = 131072;
static_assert(CTL_MOD >= CTL_ZERO_BYTES && CTL_MOD + 2 * 16 * 6144 * 4 <= 2 * MiB && (CW_CNT + 4 * 64 + 32) * 4 <= (int)CTL_ZERO_BYTES, "ctl");

constexpr int RING_BYTES = 131072;
constexpr int LTAB_OFF = 133120;
constexpr int LDSCTL_OFF = 162816;
constexpr int LDS_BYTES = 163840;
constexpr int NWAVES = 8;

#define GAS __attribute__((address_space(1)))
#define LAS __attribute__((address_space(3)))
typedef unsigned short bf16;
typedef unsigned v4u __attribute__((ext_vector_type(4)));
typedef unsigned v2u __attribute__((ext_vector_type(2)));
typedef float f32x4 __attribute__((ext_vector_type(4)));
typedef short bf16x8 __attribute__((ext_vector_type(8)));
typedef GAS unsigned gu32;
#define RLX_AGENT __ATOMIC_RELAXED, __HIP_MEMORY_SCOPE_AGENT
#define LDS_WAIT() asm volatile("s_waitcnt lgkmcnt(0)" ::: "memory")
__device__ __forceinline__ unsigned f2bf(float f) { unsigned u = __builtin_bit_cast(unsigned, f); return (u + 0x7fffu + ((u >> 16) & 1u)) >> 16; }
__device__ __forceinline__ unsigned pk2(float lo, float hi) { unsigned r; asm("v_cvt_pk_bf16_f32 %0, %1, %2" : "=v"(r) : "v"(lo), "v"(hi)); return r; }
#ifndef FP8_MASK
#define FP8_MASK 0xFE
#endif
#define FP8_ON(l, g) (((FP8_MASK) >> (4 * (l) + (g))) & 1)
#ifndef I8_MASK
#define I8_MASK 0x3
#endif
#define I8_ON(l) (((I8_MASK) >> (l)) & 1)
constexpr float WI8S = 127.0f * 32.0f / 5.5f;
#ifndef YE_FP8
#define YE_FP8 0
#endif
constexpr float W8S = 32.0f, H8S = 32.0f, Y8S = 4.0f, E8S = 8.0f;
constexpr int E8_ONE = 127, E8_W = 122, E8_H = 122, E8_Y = 125;
__device__ __forceinline__ unsigned pk4f8(float a, float b, float c, float d) {
    a = __builtin_amdgcn_fmed3f(a, -448.f, 448.f); b = __builtin_amdgcn_fmed3f(b, -448.f, 448.f); c = __builtin_amdgcn_fmed3f(c, -448.f, 448.f); d = __builtin_amdgcn_fmed3f(d, -448.f, 448.f);
    unsigned w = 0u; w = (unsigned)__builtin_amdgcn_cvt_pk_fp8_f32(a, b, (int)w, false); w = (unsigned)__builtin_amdgcn_cvt_pk_fp8_f32(c, d, (int)w, true); return w;
}
__device__ __forceinline__ unsigned pk4i8(float a, float b, float c, float d) {
    const int i0 = (int)__builtin_rintf(__builtin_amdgcn_fmed3f(a, -127.f, 127.f)), i1 = (int)__builtin_rintf(__builtin_amdgcn_fmed3f(b, -127.f, 127.f)),
              i2 = (int)__builtin_rintf(__builtin_amdgcn_fmed3f(c, -127.f, 127.f)), i3 = (int)__builtin_rintf(__builtin_amdgcn_fmed3f(d, -127.f, 127.f));
    return (unsigned)(i0 & 255) | ((unsigned)(i1 & 255) << 8) | ((unsigned)(i2 & 255) << 16) | ((unsigned)i3 << 24);
}
__device__ __forceinline__ float fexp(float x) { return __builtin_amdgcn_exp2f(x * 1.44269504f); }
__device__ __forceinline__ float flog(float x) { return __builtin_amdgcn_logf(x) * 0.69314718f; }
__device__ __forceinline__ float bf2f(unsigned short h) { return __uint_as_float((unsigned)h << 16); }
__device__ __forceinline__ float bflo(unsigned w) { return __uint_as_float(w << 16); }
__device__ __forceinline__ float bfhi(unsigned w) { return __uint_as_float(w & 0xffff0000u); }
#define DPP_F(x, ctrl) __int_as_float(__builtin_amdgcn_update_dpp(0, __float_as_int(x), (ctrl), 0xf, 0xf, true))
__device__ __forceinline__ float row_sum16(float v) {
    v += DPP_F(v, 0xB1); v += DPP_F(v, 0x4E); v += DPP_F(v, 0x141); v += DPP_F(v, 0x140);
    return v;
}
__device__ __forceinline__ float row_prefix16(float v) {
    v += DPP_F(v, 0x111); v += DPP_F(v, 0x112); v += DPP_F(v, 0x114); v += DPP_F(v, 0x118);
    return v;
}
__device__ __forceinline__ float wave_max_nonneg(float v) {
    v = fmaxf(v, DPP_F(v, 0xB1)); v = fmaxf(v, DPP_F(v, 0x4E)); v = fmaxf(v, DPP_F(v, 0x141)); v = fmaxf(v, DPP_F(v, 0x140));
    const int i = __float_as_int(v);
    return fmaxf(fmaxf(__int_as_float(__builtin_amdgcn_readlane(i, 0)), __int_as_float(__builtin_amdgcn_readlane(i, 16))), fmaxf(__int_as_float(__builtin_amdgcn_readlane(i, 32)), __int_as_float(__builtin_amdgcn_readlane(i, 48))));
}
__device__ __forceinline__ float wave_sum(float v) {
    v = row_sum16(v);
    const int i = __float_as_int(v);
    return (__int_as_float(__builtin_amdgcn_readlane(i, 0)) + __int_as_float(__builtin_amdgcn_readlane(i, 16))) + (__int_as_float(__builtin_amdgcn_readlane(i, 32)) + __int_as_float(__builtin_amdgcn_readlane(i, 48)));
}

#define XB_TMO      128
#define XB_XCNT(j)  (256  + 64 * (j))
#define XB_XSUB(j)  (1280 + 64 * (j))
#define XB_XGEN(j)  (2304 + 64 * (j))
#define XB_TOP      3328
#define XB_TOPGEN   3392
#define XCD_BAR_WORDS 3456
#define XB_SPIN_CAP (1u << 21)
__device__ __forceinline__ unsigned xb_ld(unsigned* p)              { return __hip_atomic_load(p, __ATOMIC_RELAXED, __HIP_MEMORY_SCOPE_AGENT); }
__device__ __forceinline__ unsigned xb_add(unsigned* p, unsigned v) { return __hip_atomic_fetch_add(p, v, __ATOMIC_RELAXED, __HIP_MEMORY_SCOPE_AGENT); }
__device__ __forceinline__ unsigned xb_xcc_id() { return (unsigned)__builtin_amdgcn_s_getreg((3 << 11) | 20) & 0xFu; }
#define XB_SPIN(cond, bar) do { unsigned _sp = 0; while (cond) { __builtin_amdgcn_s_sleep(1); \
    if ((++_sp & 255u) == 0u) { if (xb_ld(&(bar)[XB_TMO])) break; if (_sp > XB_SPIN_CAP) { atomicAdd(&(bar)[XB_TMO], 1u); break; } } } } while (0)
struct XcdBarrier { unsigned* bar; unsigned x; volatile LAS unsigned* st; };
__device__ __forceinline__ XcdBarrier xcd_barrier_post(unsigned* bar, volatile LAS unsigned* st) {
    XcdBarrier b; b.bar = bar; b.x = xb_xcc_id(); b.st = st;
    if (threadIdx.x == 0) (void)xb_add(&bar[XB_XCNT(b.x)], 1u);
    return b;
}
__device__ __forceinline__ void xcd_barrier_complete(unsigned* bar, unsigned x, unsigned& nloc, unsigned& nx) {
    const unsigned G = gridDim.x * gridDim.y * gridDim.z;
    unsigned sum, cnt, mine, sp = 0u;
    for (;;) {
        sum = 0u; cnt = 0u; mine = 0u;
#pragma unroll
        for (unsigned j = 0; j < 16; ++j) { const unsigned c = xb_ld(&bar[XB_XCNT(j)]); sum += c; cnt += (c > 0u) ? 1u : 0u; mine = (j == x) ? c : mine; }
        if (sum == G) break;
        __builtin_amdgcn_s_sleep(1);
        if ((++sp & 255u) == 0u) { if (xb_ld(&bar[XB_TMO])) break; if (sp > XB_SPIN_CAP) { atomicAdd(&bar[XB_TMO], 1u); break; } }
    }
    nloc = mine > 0u ? mine : 1u; nx = cnt > 0u ? cnt : 1u;
}
__device__ __forceinline__ void xcd_barrier(const XcdBarrier& b, bool leader) {
    asm volatile("s_waitcnt vmcnt(0)" ::: "memory");
    __syncthreads();
    if (leader) {
        unsigned* bar = b.bar;
        __builtin_amdgcn_s_waitcnt(0);
        unsigned nloc = b.st[0], nx = b.st[1];
        if (nloc == 0u) { xcd_barrier_complete(bar, b.x, nloc, nx); b.st[0] = nloc; b.st[1] = nx; }
        const unsigned old = xb_add(&bar[XB_XSUB(b.x)], 1u);
        const unsigned gen = old / nloc;
        if (old + 1u == (gen + 1u) * nloc) {
            __builtin_amdgcn_fence(__ATOMIC_RELEASE, "agent");
            asm volatile("s_waitcnt vmcnt(0)" ::: "memory");
            const unsigned og = xb_add(&bar[XB_TOP], 1u);
            const unsigned tg = og / nx;
            if (og + 1u == (tg + 1u) * nx) xb_add(&bar[XB_TOPGEN], 1u);
            else XB_SPIN(xb_ld(&bar[XB_TOPGEN]) == tg, bar);
            __builtin_amdgcn_fence(__ATOMIC_ACQUIRE, "agent");
            xb_add(&bar[XB_XGEN(b.x)], 1u);
            asm volatile("s_waitcnt vmcnt(0)" ::: "memory");
        } else {
            XB_SPIN(xb_ld(&bar[XB_XGEN(b.x)]) == gen, bar);
            __builtin_amdgcn_fence(__ATOMIC_ACQUIRE, "agent");
            asm volatile("s_waitcnt vmcnt(0)" ::: "memory");
        }
    }
    __syncthreads();
}

typedef const float* fptr_t;
typedef const __attribute__((address_space(4))) fptr_t* KArgPtr;
struct Frame {
    LAS unsigned char* lds;
    int tid, lane, wave, vcu, G;
    KArgPtr inp;
    float* out; unsigned char* ws;
};
enum { I_X = 0, I_C, I_WADA, I_BADA, I_GN1, I_GN2, I_WIN, I_WOUT, I_LNG, I_LNB, I_GWS, I_GBS, I_WGATE, I_BGATE, I_GLAG, I_CONVW, I_CONVB, I_RW, I_RB, I_W1, I_W3, I_W2, I_GF };
__device__ __forceinline__ bf16* wsb(const Frame& F, size_t off) { return (bf16*)(F.ws + off); }
__device__ __forceinline__ float* hsp(const Frame& F) { return (float*)(F.ws + WS_ROUTE + RT_RSTD); }
__device__ __forceinline__ bf16* h8p(const Frame& F) { return (bf16*)((unsigned char*)F.out + 96 * MiB); }
__device__ __forceinline__ const float* modp(const Frame& F, int l) { return (const float*)(F.ws + WS_CTL + CTL_MOD) + (size_t)l * 16 * 6144; }

struct TrItem { const float* W; bf16* WT; int ldw, n0, nv, k0, ldk, d0, fp8; };
constexpr int TR_IN = 16 * 45, TR_OUT = 16 * 16, TR_E = 2 * 128 + 128, TR_L = TR_IN + TR_OUT + 32 * TR_E;
__device__ __forceinline__ TrItem tr_decode(const Frame& F, int it) {
    TrItem t; const int l = it / TR_L; int r = it % TR_L; t.nv = 64; t.fp8 = 0;
    if (r < TR_IN) { const int kb = r / 45, nb = r % 45;
        if (nb < 24) { t.n0 = 64 * nb; t.d0 = t.n0; } else if (nb < 44) { t.n0 = 1552 + 64 * (nb - 24); t.d0 = 1536 + 64 * (nb - 24); } else { t.n0 = 1536; t.d0 = 2816; t.nv = 16; }
        t.W = F.inp[I_WIN] + (size_t)l * DM * PIN; t.ldw = PIN; t.k0 = 64 * kb; t.WT = wsb(F, WS_WIN) + (size_t)l * PNP * DM; t.ldk = DM; t.fp8 = I8_ON(l) ? 2 : FP8_ON(l, 0); return t; }
    r -= TR_IN;
    if (r < TR_OUT) { const int kb = r / 16, nb = r % 16;
        t.W = F.inp[I_WOUT] + (size_t)l * DM * DM; t.ldw = DM; t.n0 = 64 * nb; t.k0 = 64 * kb; t.WT = wsb(F, WS_WOUT) + (size_t)l * DM * DM; t.ldk = DM; t.d0 = 64 * nb; t.fp8 = FP8_ON(l, 1); return t; }
    r -= TR_OUT;
    const int e = r / TR_E; r %= TR_E; const size_t le = (size_t)l * NEXP + e;
    if (r < 256) { const int s = r >> 7, rr = r & 127, kb = rr / 8, nb = rr % 8;
        t.W = F.inp[s ? I_W3 : I_W1] + le * DM * DFF; t.ldw = DFF; t.n0 = 64 * nb; t.k0 = 64 * kb; t.WT = wsb(F, WS_W13) + le * DM * DM; t.ldk = DM; t.d0 = 256 * (t.n0 >> 7) + 128 * s + (t.n0 & 127); t.fp8 = FP8_ON(l, 2); return t; }
    r -= 256;
    { const int kb = r / 16, nb = r % 16; t.fp8 = FP8_ON(l, 3);
        t.W = F.inp[I_W2] + le * DFF * DM; t.ldw = DM; t.n0 = 64 * nb; t.k0 = 64 * kb; t.WT = wsb(F, WS_W2) + le * DM * DFF; t.ldk = DFF; t.d0 = 64 * nb; return t; }
}
__device__ __forceinline__ void tr_load(const TrItem& t, float (&r)[64], int lane) {
    const int kq = lane >> 4, nq = (lane & 15) * 4;
    const float* p = t.W + (size_t)(t.k0 + kq) * t.ldw + t.n0 + nq; const bool ok = nq < t.nv;
#pragma unroll
    for (int i = 0; i < 16; ++i) { const f32x4 v = ok ? __builtin_nontemporal_load((const f32x4*)(p + (size_t)(4 * i) * t.ldw)) : (f32x4){0.f, 0.f, 0.f, 0.f};
        r[4 * i] = v[0]; r[4 * i + 1] = v[1]; r[4 * i + 2] = v[2]; r[4 * i + 3] = v[3]; }
}
__device__ __forceinline__ void tr_store(const TrItem& t, const float (&r)[64], LAS float* scr, int lane, int var) {
    { const int kq = lane >> 4, nq = (lane & 15) * 4;
#pragma unroll
      for (int i = 0; i < 64; ++i) scr[(4 * (i >> 2) + kq) * 65 + nq + (i & 3)] = r[i]; }
    LDS_WAIT(); asm volatile("" ::: "memory");
    const int ck = lane & 7;
#pragma unroll
    for (int j = 0; j < 8; ++j) { const int n = (lane >> 3) + 8 * j; const LAS float* s = scr + (8 * ck) * 65 + n;
        if (var == 1) continue;
        if (t.fp8 == 2) { if (n < t.nv) *(v2u*)((unsigned char*)t.WT + (size_t)(t.d0 + n) * t.ldk + t.k0 + 8 * ck) = (v2u){pk4i8(s[0 * 65] * WI8S, s[1 * 65] * WI8S, s[2 * 65] * WI8S, s[3 * 65] * WI8S), pk4i8(s[4 * 65] * WI8S, s[5 * 65] * WI8S, s[6 * 65] * WI8S, s[7 * 65] * WI8S)}; }
        else if (t.fp8) { if (n < t.nv) *(v2u*)((unsigned char*)t.WT + (size_t)(t.d0 + n) * t.ldk + t.k0 + 8 * ck) = (v2u){pk4f8(s[0 * 65] * W8S, s[1 * 65] * W8S, s[2 * 65] * W8S, s[3 * 65] * W8S), pk4f8(s[4 * 65] * W8S, s[5 * 65] * W8S, s[6 * 65] * W8S, s[7 * 65] * W8S)}; }
        else { v4u o; o.x = pk2(s[0 * 65], s[1 * 65]); o.y = pk2(s[2 * 65], s[3 * 65]); o.z = pk2(s[4 * 65], s[5 * 65]); o.w = pk2(s[6 * 65], s[7 * 65]);
            if (n < t.nv) *(v4u*)(t.WT + (size_t)(t.d0 + n) * t.ldk + t.k0 + 8 * ck) = o; } }
    LDS_WAIT(); asm volatile("" ::: "memory");
}
__device__ __forceinline__ void p0_prologue(Frame& F, int var) {
    LAS float* scr = (LAS float*)(F.lds + F.wave * 16640);
    const int gw = F.vcu * NWAVES + F.wave, NGW = F.G * NWAVES;
    constexpr int NITEMS = 2 * TR_L;
    for (int it = gw; it < NITEMS; it += NGW) {
        const TrItem ta = tr_decode(F, NITEMS - 1 - it);
        float ra[64];
        tr_load(ta, ra, F.lane);
        if (var == 2) { float sacc = 0.f; _Pragma("unroll") for (int i = 0; i < 64; ++i) sacc += ra[i]; if (sacc == 1.2345e30f) scr[F.lane] = sacc; }
        else tr_store(ta, ra, scr, F.lane, var);
    }
    { const int idx = F.vcu * 512 + F.tid;
      if (idx < 2 * 4 * 128 * 128) { const int s = idx & 127, t = (idx >> 7) & 127; const float w = F.inp[I_GWS][idx];
          wsb(F, WS_GW)[idx] = (bf16)f2bf(((t >> 6) >= (s >> 6)) ? w : 0.f); } }
    { const int idx = F.vcu * 512 + F.tid; if (idx < 32 * 1024) wsb(F, WS_WR)[idx] = (bf16)f2bf(F.inp[I_RW][(idx & 1023) * 32 + (idx >> 10)]); }
    { const int idx = F.vcu * 512 + F.tid; if (idx < 2 * 256 * 16) wsb(F, WS_WG)[idx] = (bf16)f2bf(F.inp[I_WGATE][((idx >> 12) * 16 + (idx & 15)) * 256 + ((idx >> 4) & 255)]); }
    __syncthreads();
    {
        const int l = F.vcu >> 7, cbase = (F.vcu & 127) * 48, kg = F.tid >> 4, cl = F.tid & 15;
        LAS float* sc = (LAS float*)F.lds;
        { float cv[32];
#pragma unroll
          for (int i = 0; i < 32; ++i) cv[i] = F.inp[I_C][F.tid + 512 * i];
#pragma unroll
          for (int i = 0; i < 32; ++i) sc[F.tid + 512 * i] = cv[i] / (1.0f + __expf(-cv[i])); }
        __syncthreads();
        float acc[3][16];
#pragma unroll
        for (int q = 0; q < 3; ++q)
#pragma unroll
            for (int b = 0; b < 16; ++b) acc[q][b] = 0.f;
        const float* wp = F.inp[I_WADA] + (size_t)l * DM * 6144 + cbase + cl;
#pragma unroll 1
        for (int g8 = 0; g8 < 4; ++g8) { float wv[8][3];
#pragma unroll
            for (int i = 0; i < 8; ++i) { const size_t ko = (size_t)(kg + 32 * (8 * g8 + i)) * 6144; wv[i][0] = wp[ko]; wv[i][1] = wp[ko + 16]; wv[i][2] = wp[ko + 32]; }
#pragma unroll
            for (int i = 0; i < 8; ++i) { const int k = kg + 32 * (8 * g8 + i); const float w0 = wv[i][0], w1 = wv[i][1], w2 = wv[i][2];
#pragma unroll
                for (int b = 0; b < 16; ++b) { const float s = sc[b * 1024 + k]; acc[0][b] += s * w0; acc[1][b] += s * w1; acc[2][b] += s * w2; } } }
        __syncthreads();
        LAS float* part = (LAS float*)F.lds;
#pragma unroll
        for (int q = 0; q < 3; ++q)
#pragma unroll
            for (int b = 0; b < 16; ++b) part[(kg * 48 + cl + 16 * q) * 16 + b] = acc[q][b];
        __syncthreads();
        for (int t = F.tid; t < 768; t += 512) { const int col = t >> 4, b = t & 15; float sum = F.inp[I_BADA][l * 6144 + cbase + col];
            for (int g = 0; g < 32; ++g) sum += part[(g * 48 + col) * 16 + b];
            ((float*)(F.ws + WS_CTL + CTL_MOD))[((size_t)l * 16 + b) * 6144 + cbase + col] = sum; }
    }
}

__device__ __forceinline__ void write_normed(const f32x4 (&v)[4], float rstd, const float* g, const float* sc, const float* sh, bf16* orow, int lane) {
#pragma unroll
    for (int j = 0; j < 4; ++j) { const int c = 4 * lane + 256 * j;
        const f32x4 g4 = *(const f32x4*)(g + c), s4 = *(const f32x4*)(sc + c), h4 = *(const f32x4*)(sh + c);
        const f32x4 o = v[j] * rstd * g4 * (s4 + 1.0f) + h4;
        v2u w; w.x = pk2(o[0], o[1]); w.y = pk2(o[2], o[3]); *(v2u*)(orow + c) = w; }
}
__device__ __forceinline__ float row_rstd(const f32x4 (&v)[4]) {
    float s = 0.f;
#pragma unroll
    for (int j = 0; j < 4; ++j) s += (v[j][0] * v[j][0] + v[j][1] * v[j][1]) + (v[j][2] * v[j][2] + v[j][3] * v[j][3]);
    return 1.0f / sqrtf(wave_sum(s) * (1.0f / DM) + EPS);
}
__device__ __forceinline__ void norm_vectors(const float* g, const float* sc, const float* sh, int lane, f32x4 (&gs)[4], f32x4 (&shv)[4]) {
#pragma unroll
    for (int j = 0; j < 4; ++j) { const int c = 4 * lane + 256 * j; gs[j] = *(const f32x4*)(g + c) * (*(const f32x4*)(sc + c) + 1.0f); shv[j] = *(const f32x4*)(sh + c); }
}
__device__ __forceinline__ void store_normed(const f32x4 (&v)[4], float rstd, const f32x4 (&gs)[4], const f32x4 (&shv)[4], bf16* H, size_t row, int lane, int mode, float* hs) {
    f32x4 o[4];
#pragma unroll
    for (int j = 0; j < 4; ++j) o[j] = v[j] * rstd * gs[j] + shv[j];
    if (mode == 2) { float m = 0.f;
#pragma unroll
        for (int j = 0; j < 4; ++j) m = fmaxf(fmaxf(m, fmaxf(fabsf(o[j][0]), fabsf(o[j][1]))), fmaxf(fabsf(o[j][2]), fabsf(o[j][3])));
        m = fmaxf(wave_max_nonneg(m), 1e-20f); const float s = 127.0f / m;
#pragma unroll
        for (int j = 0; j < 4; ++j) *(unsigned*)((unsigned char*)H + row * DM + 4 * lane + 256 * j) = pk4i8(o[j][0] * s, o[j][1] * s, o[j][2] * s, o[j][3] * s);
        if (lane == 0) hs[row] = m * (1.0f / 127.0f); }
    else {
#pragma unroll
        for (int j = 0; j < 4; ++j) { if (mode == 1) *(unsigned*)((unsigned char*)H + row * DM + 4 * lane + 256 * j) = pk4f8(o[j][0], o[j][1], o[j][2], o[j][3]);
            else *(v2u*)(H + row * DM + 4 * lane + 256 * j) = (v2u){pk2(o[j][0], o[j][1]), pk2(o[j][2], o[j][3])}; } }
}
#define HMODE(l) (I8_ON(l) ? 2 : (FP8_ON(l, 0) ? 1 : 0))
__device__ __forceinline__ void p1_first_norm(Frame& F) {
    const int gw = F.vcu * NWAVES + F.wave, row0 = gw * 16, b = row0 >> 11;
    const float* mod = modp(F, 0) + b * 6144; bf16* X = wsb(F, WS_X); bf16* H = wsb(F, WS_HY);
    f32x4 gs[4], shv[4]; norm_vectors(F.inp[I_GN1], mod + 1024, mod, F.lane, gs, shv);
    for (int i = 0; i < 16; i += 2) {
        f32x4 va[4], vb[4];
#pragma unroll
        for (int j = 0; j < 4; ++j) { va[j] = __builtin_nontemporal_load((const f32x4*)(F.inp[I_X] + (size_t)(row0 + i) * DM + 4 * F.lane + 256 * j)); vb[j] = __builtin_nontemporal_load((const f32x4*)(F.inp[I_X] + (size_t)(row0 + i + 1) * DM + 4 * F.lane + 256 * j)); }
        const float ra = row_rstd(va), rb = row_rstd(vb);
#pragma unroll
        for (int j = 0; j < 4; ++j) { *(v2u*)(X + (size_t)(row0 + i) * DM + 4 * F.lane + 256 * j) = (v2u){pk2(va[j][0], va[j][1]), pk2(va[j][2], va[j][3])};
                                      *(v2u*)(X + (size_t)(row0 + i + 1) * DM + 4 * F.lane + 256 * j) = (v2u){pk2(vb[j][0], vb[j][1]), pk2(vb[j][2], vb[j][3])}; }
        store_normed(va, ra, gs, shv, HMODE(0) ? h8p(F) : H, (size_t)(row0 + i), F.lane, HMODE(0), hsp(F)); store_normed(vb, rb, gs, shv, HMODE(0) ? h8p(F) : H, (size_t)(row0 + i + 1), F.lane, HMODE(0), hsp(F));
    }
}
__device__ __forceinline__ void combine_row(const bf16* X, const bf16* YE, const float* rw, const f32x4 (&gt)[4], int row, int lane, f32x4 (&v)[4]) {
    const float w0 = rw[2 * row], w1 = rw[2 * row + 1];
#pragma unroll
    for (int j = 0; j < 4; ++j) { const int c = 4 * lane + 256 * j;
        const v2u xv = __builtin_nontemporal_load((const v2u*)(X + (size_t)row * DM + c));
        if (YE_FP8) { typedef float f32x2 __attribute__((ext_vector_type(2)));
            const unsigned q0 = *(const unsigned*)((const unsigned char*)YE + (size_t)row * DM + c), q1 = *(const unsigned*)((const unsigned char*)YE + (size_t)(NTOK + row) * DM + c);
            const f32x2 a0 = __builtin_amdgcn_cvt_pk_f32_fp8(q0, false), a1 = __builtin_amdgcn_cvt_pk_f32_fp8(q0, true), b0 = __builtin_amdgcn_cvt_pk_f32_fp8(q1, false), b1 = __builtin_amdgcn_cvt_pk_f32_fp8(q1, true);
            const float u0 = w0 * (1.0f / E8S), u1 = w1 * (1.0f / E8S);
            v[j][0] = bflo(xv.x) + gt[j][0] * (u0 * a0.x + u1 * b0.x); v[j][1] = bfhi(xv.x) + gt[j][1] * (u0 * a0.y + u1 * b0.y);
            v[j][2] = bflo(xv.y) + gt[j][2] * (u0 * a1.x + u1 * b1.x); v[j][3] = bfhi(xv.y) + gt[j][3] * (u0 * a1.y + u1 * b1.y); }
        else { const v2u y0 = __builtin_nontemporal_load((const v2u*)(YE + (size_t)row * DM + c)), y1 = __builtin_nontemporal_load((const v2u*)(YE + (size_t)(NTOK + row) * DM + c));
            v[j][0] = bflo(xv.x) + gt[j][0] * (w0 * bflo(y0.x) + w1 * bflo(y1.x)); v[j][1] = bfhi(xv.x) + gt[j][1] * (w0 * bfhi(y0.x) + w1 * bfhi(y1.x));
            v[j][2] = bflo(xv.y) + gt[j][2] * (w0 * bflo(y0.y) + w1 * bflo(y1.y)); v[j][3] = bfhi(xv.y) + gt[j][3] * (w0 * bfhi(y0.y) + w1 * bfhi(y1.y)); } }
}
__device__ __forceinline__ void p9_combine(Frame& F, int l, bool dry  ) {
    const int gw = F.vcu * NWAVES + F.wave, row0 = gw * 16, b = row0 >> 11;
    const float* mod = modp(F, l) + b * 6144; const bf16* X = wsb(F, WS_X); bf16* Xo = dry ? (bf16*)F.out : wsb(F, WS_X); bf16* H = dry ? (bf16*)F.out + (size_t)NTOK * DM : wsb(F, WS_HY); const bf16* YE = wsb(F, WS_YE);
    const float* rw = (const float*)(F.ws + WS_ROUTE + RT_W);
    f32x4 gt[4], gs[4], shv[4];
#pragma unroll
    for (int j = 0; j < 4; ++j) gt[j] = *(const f32x4*)(mod + 5120 + 4 * F.lane + 256 * j);
    if (l == NLAYER - 1) {
#pragma unroll
        for (int j = 0; j < 4; ++j) gs[j] = *(const f32x4*)(F.inp[I_GF] + 4 * F.lane + 256 * j);
    } else { const float* mod1 = modp(F, l + 1) + b * 6144; norm_vectors(F.inp[I_GN1] + (l + 1) * DM, mod1 + 1024, mod1, F.lane, gs, shv); }
    for (int i = 0; i < 16; i += 2) {
        f32x4 va[4], vb[4]; combine_row(X, YE, rw, gt, row0 + i, F.lane, va); combine_row(X, YE, rw, gt, row0 + i + 1, F.lane, vb);
        const float ra = row_rstd(va), rb = row_rstd(vb);
        if (l == NLAYER - 1) {
#pragma unroll
            for (int j = 0; j < 4; ++j) { *(f32x4*)(F.out + (size_t)(row0 + i) * DM + 4 * F.lane + 256 * j) = va[j] * ra * gs[j]; *(f32x4*)(F.out + (size_t)(row0 + i + 1) * DM + 4 * F.lane + 256 * j) = vb[j] * rb * gs[j]; }
        } else {
#pragma unroll
            for (int j = 0; j < 4; ++j) { *(v2u*)(Xo + (size_t)(row0 + i) * DM + 4 * F.lane + 256 * j) = (v2u){pk2(va[j][0], va[j][1]), pk2(va[j][2], va[j][3])};
                                          *(v2u*)(Xo + (size_t)(row0 + i + 1) * DM + 4 * F.lane + 256 * j) = (v2u){pk2(vb[j][0], vb[j][1]), pk2(vb[j][2], vb[j][3])}; }
            store_normed(va, ra, gs, shv, HMODE(l + 1) ? h8p(F) : H, (size_t)(row0 + i), F.lane, HMODE(l + 1), hsp(F)); store_normed(vb, rb, gs, shv, HMODE(l + 1) ? h8p(F) : H, (size_t)(row0 + i + 1), F.lane, HMODE(l + 1), hsp(F));
        }
    }
}
constexpr int P64 = 144, P128 = 272;
typedef unsigned short u16x4 __attribute__((ext_vector_type(4)));
__device__ __forceinline__ bf16x8 ldfrag(const LAS unsigned char* tile, int pitch, int r0, int k0, int fr, int fq) { return *(const LAS bf16x8*)(tile + (r0 + fr) * pitch + (k0 + 8 * fq) * 2); }
__device__ __forceinline__ f32x4 mma16(bf16x8 a, bf16x8 b, f32x4 c) { return __builtin_amdgcn_mfma_f32_16x16x32_bf16(b, a, c, 0, 0, 0); }
__device__ __forceinline__ void lbar() { asm volatile("s_waitcnt lgkmcnt(0)" ::: "memory"); __builtin_amdgcn_s_barrier(); asm volatile("" ::: "memory"); }
__device__ __forceinline__ void trfrag2(unsigned a0, unsigned a1, unsigned b0, unsigned b1, bf16x8& fa, bf16x8& fb) {
    u16x4 r0, r1, r2, r3;
    asm volatile("ds_read_b64_tr_b16 %0, %4\n\tds_read_b64_tr_b16 %1, %5\n\tds_read_b64_tr_b16 %2, %6\n\tds_read_b64_tr_b16 %3, %7\n\ts_waitcnt lgkmcnt(0)"
                 : "=&v"(r0), "=&v"(r1), "=&v"(r2), "=&v"(r3) : "v"(a0), "v"(a1), "v"(b0), "v"(b1) : "memory");
    fa = __builtin_bit_cast(bf16x8, __builtin_shufflevector(r0, r1, 0, 1, 2, 3, 4, 5, 6, 7)); fb = __builtin_bit_cast(bf16x8, __builtin_shufflevector(r2, r3, 0, 1, 2, 3, 4, 5, 6, 7));
}
__device__ __forceinline__ unsigned offb(unsigned row, unsigned ch) { return 256u * row + 16u * (ch ^ (((row & 3) << 2) | ((row >> 2) & 3))); }
constexpr int MX_TB = 0  , MX_SSQ = 5120, MX_GG = 5632  , MX_QT = 8192, MX_KT = MX_QT + 64 * P64, MX_QH = MX_KT + 64 * P64, MX_SC = MX_QH + 64 * P64,
              MX_ST = MX_SC + 64 * P64, MX_VI = MX_ST + 128 * P64, MX_WG = MX_VI + 64 * 256  , MX_BGL = MX_WG + 8192  , MX_END = MX_BGL + 1024;
constexpr int MS_KI = 8192, MS_VI = MS_KI + 64 * P64, MS_SET = 64 * P64 + 64 * 80;
constexpr int MX_VN = 8192;
static_assert(MX_END <= RING_BYTES && MX_VN + 256 * P128 <= RING_BYTES && (MX_VI & 255) == 0, "mixer LDS");

__device__ __forceinline__ void gate_stage(Frame& F, int l) {
    *(LAS v4u*)(F.lds + MX_WG + F.tid * 16) = *(const v4u*)(wsb(F, WS_WG) + (size_t)l * 4096 + F.tid * 8);
    if (F.tid < 256) ((LAS float*)(F.lds + MX_BGL))[F.tid] = F.inp[I_BGATE][l * 256 + F.tid];
}
__device__ __forceinline__ v4u gate_load(Frame& F, int tok0) {
    const int fr = F.lane & 15, fq = F.lane >> 4, mt = F.wave >> 1;
    return *(const v4u*)(wsb(F, WS_P) + (size_t)(tok0 + 16 * mt + fr) * PNP + PC_G + 8 * (fq & 1));
}
__device__ __forceinline__ void gate_prefix(Frame& F, const v4u ga, int h, float (&pb)[2][4], LAS float* tb) {
    const int fr = F.lane & 15, fq = F.lane >> 4, mt = F.wave >> 1, nt0 = 2 * (F.wave & 1);
    const v4u zero4 = (v4u){0u, 0u, 0u, 0u};
    const bf16x8 a = __builtin_bit_cast(bf16x8, (fq < 2) ? ga : zero4);
#pragma unroll
    for (int q = 0; q < 2; ++q) { const int kt = h * 64 + 16 * (nt0 + q);
        const v4u wv = *(const LAS v4u*)(F.lds + MX_WG + ((kt + fr) * 16 + 8 * (fq & 1)) * 2);
        const bf16x8 bw = __builtin_bit_cast(bf16x8, (fq < 2) ? wv : zero4);
        const f32x4 z = mma16(a, bw, *(const LAS f32x4*)(F.lds + MX_BGL + (kt + 4 * fq) * 4));
#pragma unroll
        for (int r = 0; r < 4; ++r) { float x = (fminf(z[r], 0.f) - flog(1.0f + fexp(-fabsf(z[r])))) * (1.0f / 16.0f);
            pb[q][r] = row_prefix16(x); }
        const int k0 = 16 * (nt0 + q) + 4 * fq;
        if (fr == 15) *(LAS f32x4*)(tb + mt * 64 + k0) = (f32x4){pb[q][0], pb[q][1], pb[q][2], pb[q][3]};
        if (mt == 2 && fr == 0) *(LAS f32x4*)(tb + 256 + k0) = (f32x4){pb[q][0], pb[q][1], pb[q][2], pb[q][3]}; }
}
__device__ __forceinline__ void gate_finish(Frame& F, const LAS float* tb, float (&pb)[2][4], float (&bref)[2][4], float (&blast)[2][4]) {
    const int fq = F.lane >> 4, mt = F.wave >> 1, nt0 = 2 * (F.wave & 1);
#pragma unroll
    for (int q = 0; q < 2; ++q) { const int k0 = 16 * (nt0 + q) + 4 * fq;
        const f32x4 t0 = *(const LAS f32x4*)(tb + k0), t1 = *(const LAS f32x4*)(tb + 64 + k0), t2 = *(const LAS f32x4*)(tb + 128 + k0), t3 = *(const LAS f32x4*)(tb + 192 + k0), g32 = *(const LAS f32x4*)(tb + 256 + k0);
#pragma unroll
        for (int r = 0; r < 4; ++r) { const float off = ((mt > 0) ? t0[r] : 0.f) + ((mt > 1) ? t1[r] : 0.f) + ((mt > 2) ? t2[r] : 0.f);
            pb[q][r] += off; bref[q][r] = t0[r] + t1[r] + g32[r]; blast[q][r] = (t0[r] + t1[r]) + (t2[r] + t3[r]); } }
}

__device__ __forceinline__ bf16* gla_arr(const Frame& F, int which) { return (bf16*)F.out + (size_t)(16 + 8 * which) * 1024 * 1024; }
struct PrepIn { v4u ga; v2u q[2], k[2]; };
__device__ __forceinline__ void prep_load(Frame& F, int item, PrepIn& p) {
    const int fr = F.lane & 15, fq = F.lane >> 4, mt = F.wave >> 1, nt0 = 2 * (F.wave & 1), h = item & 3, tok0 = (item >> 2) * 64;
    p.ga = gate_load(F, tok0);
    const bf16* pr = wsb(F, WS_P) + (size_t)(tok0 + 16 * mt + fr) * PNP + h * 64 + 4 * fq;
#pragma unroll
    for (int q = 0; q < 2; ++q) { p.q[q] = *(const v2u*)(pr + PC_Q + 16 * (nt0 + q)); p.k[q] = *(const v2u*)(pr + PC_K + 16 * (nt0 + q)); }
}
__device__ __forceinline__ void p3p_gla_prep(Frame& F, int l) {
    const int fr = F.lane & 15, fq = F.lane >> 4, w = F.wave, mt = w >> 1, nt0 = 2 * (w & 1);
    PrepIn ring[3]; prep_load(F, F.vcu * 8, ring[0]); prep_load(F, F.vcu * 8 + 1, ring[1]); ring[2] = ring[0];
    bf16* QT = gla_arr(F, 0); bf16* KT = gla_arr(F, 1); bf16* QH = gla_arr(F, 2); bf16* KH = gla_arr(F, 3); float* dec = (float*)(F.ws + WS_ROUTE + RT_DEC);
    __syncthreads();
    gate_stage(F, l);
    __syncthreads();
    for (int i3 = 0; i3 < 9; i3 += 3) {
#pragma unroll
      for (int j = 0; j < 3; ++j) { const int ii = i3 + j; if (ii < 8) {
        const PrepIn& cur = ring[j];
        const int item = F.vcu * 8 + ii, h = item & 3, tok0 = (item >> 2) * 64;
        LAS float* tb = (LAS float*)(F.lds + MX_TB) + (ii & 1) * 320;
        float pb[2][4], bref[2][4], blast[2][4];
        gate_prefix(F, cur.ga, h, pb, tb);
        lbar();
        gate_finish(F, tb, pb, bref, blast);
#pragma unroll
        for (int q = 0; q < 2; ++q) { const size_t off = (size_t)(tok0 + 16 * mt + fr) * 256 + h * 64 + 16 * (nt0 + q) + 4 * fq;
            const float q0 = bflo(cur.q[q].x) * 0.125f, q1 = bfhi(cur.q[q].x) * 0.125f, q2 = bflo(cur.q[q].y) * 0.125f, q3 = bfhi(cur.q[q].y) * 0.125f;
            const float k0 = bflo(cur.k[q].x), k1 = bfhi(cur.k[q].x), k2 = bflo(cur.k[q].y), k3 = bfhi(cur.k[q].y);
            const float e0 = fexp(pb[q][0] - bref[q][0]), e1 = fexp(pb[q][1] - bref[q][1]), e2 = fexp(pb[q][2] - bref[q][2]), e3 = fexp(pb[q][3] - bref[q][3]);
            *(v2u*)(QT + off) = (v2u){pk2(q0 * e0, q1 * e1), pk2(q2 * e2, q3 * e3)};
            *(v2u*)(KT + off) = (v2u){pk2(k0 * fexp(bref[q][0] - pb[q][0]), k1 * fexp(bref[q][1] - pb[q][1])), pk2(k2 * fexp(bref[q][2] - pb[q][2]), k3 * fexp(bref[q][3] - pb[q][3]))};
            *(v2u*)(QH + off) = (v2u){pk2(q0 * fexp(pb[q][0]), q1 * fexp(pb[q][1])), pk2(q2 * fexp(pb[q][2]), q3 * fexp(pb[q][3]))};
            *(v2u*)(KH + off) = (v2u){pk2(k0 * fexp(blast[q][0] - pb[q][0]), k1 * fexp(blast[q][1] - pb[q][1])), pk2(k2 * fexp(blast[q][2] - pb[q][2]), k3 * fexp(blast[q][3] - pb[q][3]))};
            if (mt == 0 && fr == 0) *(f32x4*)(dec + item * 64 + 16 * (nt0 + q) + 4 * fq) = (f32x4){fexp(blast[q][0]), fexp(blast[q][1]), fexp(blast[q][2]), fexp(blast[q][3])}; }
        if (ii + 2 < 8) prep_load(F, item + 2, ring[(j + 2) % 3]);
      } }
    }
}

struct StateIn { v4u kh; v4u v; f32x4 dc; };
__device__ __forceinline__ void state_load(Frame& F, int b, int n, int h, int vq, StateIn& s) {
    const int fq = F.lane >> 4, ntk = F.wave & 3; const int tok0 = b * SEQ + 64 * n, item = (b * 32 + n) * 4 + h;
    s.kh = *(const v4u*)(gla_arr(F, 3) + (size_t)(tok0 + (F.tid >> 3)) * 256 + h * 64 + 8 * (F.tid & 7));
    const int c = F.tid & 255; s.v = *(const v4u*)(wsb(F, WS_P) + (size_t)(tok0 + (c >> 2)) * PNP + PC_V + h * 128 + 32 * vq + 8 * (c & 3));
    s.dc = *(const f32x4*)((const float*)(F.ws + WS_ROUTE + RT_DEC) + item * 64 + 16 * ntk + 4 * fq);
}
__device__ __forceinline__ void p3a_gla_state(Frame& F, int l, int var) {
    const int fr = F.lane & 15, fq = F.lane >> 4, w = F.wave, mtv = w >> 2, ntk = w & 3;
    const int b = F.vcu >> 4, h = (F.vcu >> 2) & 3, vq = F.vcu & 3;
    StateIn ring[6];
#pragma unroll
    for (int j = 0; j < 6; ++j) state_load(F, b, j, h, vq, ring[j]);
    f32x4 S = (f32x4){0.f, 0.f, 0.f, 0.f};
    const unsigned rq = (unsigned)(8 * fq + (fr >> 2)), cp = (unsigned)(4 * (fr & 3));
    const unsigned av = (unsigned)MS_VI + rq * 80u + (16u * mtv + cp) * 2u, ak = (unsigned)MS_KI + rq * (unsigned)P64 + (16u * ntk + cp) * 2u;
    bf16* kvo = (bf16*)F.out;
    __syncthreads();
    for (int n6 = 0; n6 < 36; n6 += 6) {
#pragma unroll
      for (int j = 0; j < 6; j += 2) { const int n = n6 + j; if (n < 32) {
        const unsigned sb = (unsigned)(((n >> 1) & 1) * 2 * MS_SET);
        *(LAS v4u*)(F.lds + sb + MS_KI + (F.tid >> 3) * P64 + (F.tid & 7) * 16) = ring[j].kh; *(LAS v4u*)(F.lds + sb + MS_KI + MS_SET + (F.tid >> 3) * P64 + (F.tid & 7) * 16) = ring[j + 1].kh;
        if (F.tid < 256) { *(LAS v4u*)(F.lds + sb + MS_VI + (F.tid >> 2) * 80 + (F.tid & 3) * 16) = ring[j].v; *(LAS v4u*)(F.lds + sb + MS_VI + MS_SET + (F.tid >> 2) * 80 + (F.tid & 3) * 16) = ring[j + 1].v; }
        const f32x4 d0 = ring[j].dc, d1 = ring[j + 1].dc;
        if (n + 6 < 32 && var != 1) { state_load(F, b, n + 6, h, vq, ring[j]); state_load(F, b, n + 7, h, vq, ring[j + 1]); }
        lbar();
        f32x4 kv0 = (f32x4){0.f, 0.f, 0.f, 0.f}, kv1 = kv0;
#pragma unroll
        for (int ks = 0; ks < 2; ++ks) { bf16x8 fa, fb; const unsigned oa = sb + ks * 32u * 80u, ob = sb + ks * 32u * (unsigned)P64;
            trfrag2(av + oa, av + oa + 4u * 80u, ak + ob, ak + ob + 4u * (unsigned)P64, fa, fb); kv0 = mma16(fa, fb, kv0);
            trfrag2(av + (unsigned)MS_SET + oa, av + (unsigned)MS_SET + oa + 4u * 80u, ak + (unsigned)MS_SET + ob, ak + (unsigned)MS_SET + ob + 4u * (unsigned)P64, fa, fb); kv1 = mma16(fa, fb, kv1); }
        const size_t o0 = (size_t)((b * 32 + n) * 4 + h) * 8192 + (32 * vq + 16 * mtv + fr) * 64 + 16 * ntk + 4 * fq;
        if (var != 2) *(v2u*)(kvo + o0) = (v2u){pk2(S[0], S[1]), pk2(S[2], S[3])};
        S = d0 * S + kv0;
        if (var != 2) *(v2u*)(kvo + o0 + 4 * 8192) = (v2u){pk2(S[0], S[1]), pk2(S[2], S[3])};
        S = d1 * S + kv1;
      } }
    }
}

constexpr int MO_BASE = 8192, MO_HALF = 71680;
constexpr int MO_QT = 0, MO_KT = 9216, MO_QH = 18432, MO_SC = 27648, MO_ST = 36864, MO_VI = 55296;
static_assert(MO_BASE + 2 * MO_HALF <= LDSCTL_OFF && ((MO_BASE + MO_VI) & 255) == 0 && (MO_HALF & 255) == 0, "mixer-out LDS");
struct OutIn { v4u qt[2], kt[2], qh[2]; v4u v[4]; v4u s[4]; };
__device__ __forceinline__ void out_load(Frame& F, int item, OutIn& o) {
    const int h = item & 3, tok0 = (item >> 2) * 64, t8 = F.tid & 255;
    const bf16* P = wsb(F, WS_P);
#pragma unroll
    for (int i = 0; i < 2; ++i) { const int c = t8 + 256 * i; const size_t go = (size_t)(tok0 + (c >> 3)) * 256 + h * 64 + 8 * (c & 7);
        o.qt[i] = __builtin_nontemporal_load((const v4u*)(gla_arr(F, 0) + go)); o.kt[i] = __builtin_nontemporal_load((const v4u*)(gla_arr(F, 1) + go)); o.qh[i] = __builtin_nontemporal_load((const v4u*)(gla_arr(F, 2) + go)); }
#pragma unroll
    for (int i = 0; i < 4; ++i) { const int c = t8 + 256 * i; o.v[i] = __builtin_nontemporal_load((const v4u*)(P + (size_t)(tok0 + (c >> 4)) * PNP + PC_V + h * 128 + 8 * (c & 15)));
        o.s[i] = __builtin_nontemporal_load((const v4u*)((const bf16*)F.out + (size_t)item * 8192 + (size_t)c * 8)); }
}
__device__ __forceinline__ void p3c_mixer_out(Frame& F, int l) {
    const int fr = F.lane & 15, fq = F.lane >> 4, w = F.wave, half = w >> 2, mt = w & 3, t8 = F.tid & 255;
    const bf16* P = wsb(F, WS_P); bf16* Y = wsb(F, WS_HY); unsigned char* Y8 = F.ws + WS_HY; const bool y8 = FP8_ON(l, 1);
    {
    LAS unsigned char* L = F.lds + MO_BASE + half * MO_HALF;
    const unsigned lvi = (unsigned)(MO_BASE + half * MO_HALF + MO_VI);
    OutIn cur;
    out_load(F, F.vcu * 8 + half, cur);
    const unsigned rq = (unsigned)(8 * fq + (fr >> 2)), ch0 = (unsigned)((fr & 3) >> 1), c8 = (unsigned)(8 * (fr & 1));
    __syncthreads();
    ((LAS float*)(F.lds + MX_GG))[F.tid] = F.inp[I_GLAG][l * 512 + F.tid];
    for (int it = 0; it < 4; ++it) {
      {
        const int item = F.vcu * 8 + 2 * it + half, h = item & 3, tok0 = (item >> 2) * 64;
        const int i = 16 * mt + fr;
        v2u ogv[8];
#pragma unroll
        for (int q = 0; q < 8; ++q) ogv[q] = *(const v2u*)(P + (size_t)(tok0 + i) * PNP + PC_OG + h * 128 + 16 * q + 4 * fq);
        lbar();
#pragma unroll
        for (int k = 0; k < 2; ++k) { const int c = t8 + 256 * k, to = (c >> 3) * P64 + (c & 7) * 16;
            *(LAS v4u*)(L + MO_QT + to) = cur.qt[k]; *(LAS v4u*)(L + MO_KT + to) = cur.kt[k]; *(LAS v4u*)(L + MO_QH + to) = cur.qh[k]; }
#pragma unroll
        for (int k = 0; k < 4; ++k) { const unsigned c = (unsigned)(t8 + 256 * k); *(LAS v4u*)(L + MO_VI + offb(c >> 4, c & 15)) = cur.v[k];
            *(LAS v4u*)(L + MO_ST + (c >> 3) * P64 + (c & 7) * 16) = cur.s[k]; }
        if (it + 1 < 4) out_load(F, item + 2, cur);
        lbar();
        {
          const bf16x8 a0 = ldfrag(L + MO_QT, P64, 16 * mt, 0, fr, fq), a1 = ldfrag(L + MO_QT, P64, 16 * mt, 32, fr, fq);
#pragma unroll
          for (int nt = 0; nt < 4; ++nt) { f32x4 c = (f32x4){0.f, 0.f, 0.f, 0.f};
              c = mma16(a0, ldfrag(L + MO_KT, P64, 16 * nt, 0, fr, fq), c); c = mma16(a1, ldfrag(L + MO_KT, P64, 16 * nt, 32, fr, fq), c);
              const int j0 = 16 * nt + 4 * fq;
              const float c0 = (j0 + 0 <= i) ? c[0] : 0.f, c1 = (j0 + 1 <= i) ? c[1] : 0.f, c2 = (j0 + 2 <= i) ? c[2] : 0.f, c3 = (j0 + 3 <= i) ? c[3] : 0.f;
              *(LAS v2u*)(L + MO_SC + i * P64 + 2 * j0) = (v2u){pk2(c0, c1), pk2(c2, c3)}; } }
        lbar();
        f32x4 acc[8];
#pragma unroll
        for (int q = 0; q < 8; ++q) acc[q] = (f32x4){0.f, 0.f, 0.f, 0.f};
#pragma unroll
        for (int ks = 0; ks < 2; ++ks) { const bf16x8 a1 = ldfrag(L + MO_SC, P64, 16 * mt, 32 * ks, fr, fq), a2 = ldfrag(L + MO_QH, P64, 16 * mt, 32 * ks, fr, fq);
            const unsigned r0 = 32u * ks + rq, r1 = r0 + 4u;
#pragma unroll
            for (int q = 0; q < 8; q += 2) { const unsigned cA = 2u * q + ch0, cB = cA + 2u; bf16x8 va, vb;
                trfrag2(lvi + offb(r0, cA) + c8, lvi + offb(r1, cA) + c8, lvi + offb(r0, cB) + c8, lvi + offb(r1, cB) + c8, va, vb);
                acc[q] = mma16(a1, va, acc[q]); acc[q + 1] = mma16(a1, vb, acc[q + 1]); }
#pragma unroll
            for (int q = 0; q < 8; ++q) acc[q] = mma16(a2, ldfrag(L + MO_ST, P64, 16 * q, 32 * ks, fr, fq), acc[q]); }
        float ss = 0.f;
#pragma unroll
        for (int q = 0; q < 8; ++q) ss += (acc[q][0] * acc[q][0] + acc[q][1] * acc[q][1]) + (acc[q][2] * acc[q][2] + acc[q][3] * acc[q][3]);
        ss += __shfl_xor(ss, 16); ss += __shfl_xor(ss, 32);
        const float rn = 1.0f / sqrtf(ss * (1.0f / 128.0f) + EPS);
#pragma unroll
        for (int q = 0; q < 8; ++q) { const int col = h * 128 + 16 * q + 4 * fq; const size_t tok = (size_t)(tok0 + i);
            const v2u og = ogv[q]; const f32x4 gg = *(const LAS f32x4*)(F.lds + MX_GG + col * 4);
            const float o0 = bflo(og.x), o1 = bfhi(og.x), o2 = bflo(og.y), o3 = bfhi(og.y);
            const float y0 = acc[q][0] * rn * gg[0] * o0 * __builtin_amdgcn_rcpf(1.0f + fexp(-o0)), y1 = acc[q][1] * rn * gg[1] * o1 * __builtin_amdgcn_rcpf(1.0f + fexp(-o1));
            const float y2 = acc[q][2] * rn * gg[2] * o2 * __builtin_amdgcn_rcpf(1.0f + fexp(-o2)), y3 = acc[q][3] * rn * gg[3] * o3 * __builtin_amdgcn_rcpf(1.0f + fexp(-o3));
            if (y8) *(unsigned*)(Y8 + tok * DM + 256 + col) = pk4f8(y0 * Y8S, y1 * Y8S, y2 * Y8S, y3 * Y8S); else *(v2u*)(Y + tok * DM + 256 + col) = (v2u){pk2(y0, y1), pk2(y2, y3)}; }
      }
    }
    }
    const int tokb = F.vcu * 128;
    __syncthreads();
    const bf16* GWp = wsb(F, WS_GW) + (size_t)l * 4 * 128 * 128; const int gt = 16 * w + fr;
    bf16x8 gaw[4][4]; v2u guu[4][4]; float gbs[4];
    {
      const f32x4 lg4 = *(const f32x4*)(F.inp[I_LNG] + l * 256 + 4 * F.lane), lb4 = *(const f32x4*)(F.inp[I_LNB] + l * 256 + 4 * F.lane);
      v2u xin[16];
#pragma unroll
      for (int i = 0; i < 16; ++i) xin[i] = *(const v2u*)(P + (size_t)(tokb + 16 * w + i) * PNP + PC_VV + 4 * F.lane);
#pragma unroll
      for (int h = 0; h < 4; ++h) { gbs[h] = F.inp[I_GBS][(l * 4 + h) * 128 + gt];
#pragma unroll
          for (int ks = 0; ks < 4; ++ks) gaw[h][ks] = *(const bf16x8*)(GWp + ((size_t)h * 128 + gt) * 128 + 32 * ks + 8 * fq);
#pragma unroll
          for (int q = 0; q < 4; ++q) guu[h][q] = *(const v2u*)(P + (size_t)(tokb + gt) * PNP + PC_U + h * 64 + 16 * q + 4 * fq); }
      unsigned o[4][8];
#pragma unroll
      for (int i = 0; i < 16; i += 2) { float y[2][4];
#pragma unroll
          for (int e = 0; e < 2; ++e) { float x[4] = {bflo(xin[i + e].x), bfhi(xin[i + e].x), bflo(xin[i + e].y), bfhi(xin[i + e].y)};
              const float mu = wave_sum((x[0] + x[1]) + (x[2] + x[3])) * (1.0f / 256.0f); float vr = 0.f;
#pragma unroll
              for (int q = 0; q < 4; ++q) { x[q] -= mu; vr += x[q] * x[q]; }
              const float rs = 1.0f / sqrtf(wave_sum(vr) * (1.0f / 256.0f) + EPS);
#pragma unroll
              for (int q = 0; q < 4; ++q) y[e][q] = x[q] * rs * lg4[q] + lb4[q]; }
#pragma unroll
          for (int q = 0; q < 4; ++q) o[q][i >> 1] = pk2(y[0][q], y[1][q]); }
#pragma unroll
      for (int q = 0; q < 4; ++q) { LAS unsigned char* d = F.lds + MX_VN + (4 * F.lane + q) * P128 + 32 * w;
          *(LAS v4u*)d = (v4u){o[q][0], o[q][1], o[q][2], o[q][3]}; *(LAS v4u*)(d + 16) = (v4u){o[q][4], o[q][5], o[q][6], o[q][7]}; } }
    __syncthreads();
    { const size_t tok = (size_t)(tokb + gt);
      const int nks = (w < 4) ? 2 : 4;
#pragma unroll
      for (int h = 0; h < 4; ++h) {
          f32x4 acc[4];
#pragma unroll
          for (int q = 0; q < 4; ++q) acc[q] = (f32x4){0.f, 0.f, 0.f, 0.f};
#pragma unroll
          for (int ks = 0; ks < 4; ++ks) { if (ks < nks) {
#pragma unroll
              for (int q = 0; q < 4; ++q) acc[q] = mma16(gaw[h][ks], ldfrag(F.lds + MX_VN, P128, h * 64 + 16 * q, 32 * ks, fr, fq), acc[q]); } }
          const float bs = gbs[h];
#pragma unroll
          for (int q = 0; q < 4; ++q) { const int c = h * 64 + 16 * q + 4 * fq; const v2u u = guu[h][q];
              const float a0 = bflo(u.x) * (acc[q][0] + bs), a1 = bfhi(u.x) * (acc[q][1] + bs), a2 = bflo(u.y) * (acc[q][2] + bs), a3 = bfhi(u.y) * (acc[q][3] + bs);
              if (y8) *(unsigned*)(Y8 + tok * DM + c) = pk4f8(a0 * Y8S, a1 * Y8S, a2 * Y8S, a3 * Y8S); else *(v2u*)(Y + tok * DM + c) = (v2u){pk2(a0, a1), pk2(a2, a3)}; }
      } }
    { const int c = (F.tid & 31) * 8, tg = F.tid >> 5;
      float cw0[8], cw1[8], cw2[8], cbb[8];
#pragma unroll
      for (int e = 0; e < 8; ++e) { const float* cw = F.inp[I_CONVW] + l * 3 * 256 + c + e; cw0[e] = cw[0]; cw1[e] = cw[256]; cw2[e] = cw[512]; cbb[e] = F.inp[I_CONVB][l * 256 + c + e]; }
      const size_t tok0 = (size_t)(tokb + 8 * tg); const int tseq0 = (int)(tok0 & (SEQ - 1));
      v4u ca[10], cxv[10], gbv[8];
#pragma unroll
      for (int j = 0; j < 10; ++j) { const bool ok = (j >= 2) || (tseq0 + j - 2 >= 0);
          if (ok) { ca[j] = *(const v4u*)(P + (tok0 + j - 2) * PNP + PC_CC + c); cxv[j] = *(const v4u*)(P + (tok0 + j - 2) * PNP + PC_CX + c); }
          else { ca[j] = (v4u){0u, 0u, 0u, 0u}; cxv[j] = (v4u){0u, 0u, 0u, 0u}; } }
#pragma unroll
      for (int k = 0; k < 8; ++k) gbv[k] = __builtin_nontemporal_load((const v4u*)(P + (tok0 + k) * PNP + PC_CB + c));
      float z[10][8];
#pragma unroll
      for (int j = 0; j < 10; ++j) { const v4u a = ca[j], x = cxv[j];
          z[j][0] = bflo(a.x) * bflo(x.x); z[j][1] = bfhi(a.x) * bfhi(x.x); z[j][2] = bflo(a.y) * bflo(x.y); z[j][3] = bfhi(a.y) * bfhi(x.y);
          z[j][4] = bflo(a.z) * bflo(x.z); z[j][5] = bfhi(a.z) * bfhi(x.z); z[j][6] = bflo(a.w) * bflo(x.w); z[j][7] = bfhi(a.w) * bfhi(x.w); }
#pragma unroll
      for (int k = 0; k < 8; ++k) { const size_t tok = tok0 + k; const v4u gb = gbv[k];
        const float cbv[8] = {bflo(gb.x), bfhi(gb.x), bflo(gb.y), bfhi(gb.y), bflo(gb.z), bfhi(gb.z), bflo(gb.w), bfhi(gb.w)};
        float y[8];
#pragma unroll
        for (int e = 0; e < 8; ++e) y[e] = cbv[e] * (cbb[e] + cw0[e] * z[k][e] + cw1[e] * z[k + 1][e] + cw2[e] * z[k + 2][e]);
        if (y8) *(v2u*)(Y8 + tok * DM + 768 + c) = (v2u){pk4f8(y[0] * Y8S, y[1] * Y8S, y[2] * Y8S, y[3] * Y8S), pk4f8(y[4] * Y8S, y[5] * Y8S, y[6] * Y8S, y[7] * Y8S)};
        else *(v4u*)(Y + tok * DM + 768 + c) = (v4u){pk2(y[0], y[1]), pk2(y[2], y[3]), pk2(y[4], y[5]), pk2(y[6], y[7])}; } }
}
constexpr int LT_CNT = 0, LT_BASE = 32, LT_SEG = 64, LT_REC = 128, LT_TILE = 1280, LT_ROW = 1664;
static_assert(LTAB_OFF + (LT_ROW + 5 * 256) * 4 <= LDSCTL_OFF, "LTAB");
__device__ __forceinline__ void norm2_vectors(Frame& F, int l, int b, f32x4 (&gs)[4], f32x4 (&sh)[4]) {
    const float* mod = modp(F, l) + b * 6144;
#pragma unroll
    for (int j = 0; j < 4; ++j) { const int c = 4 * F.lane + 256 * j; const f32x4 g4 = *(const f32x4*)(F.inp[I_GN2] + l * DM + c), s4 = *(const f32x4*)(mod + 4096 + c);
        gs[j] = g4 * (s4 + 1.0f); sh[j] = *(const f32x4*)(mod + 3072 + c); }
}
__device__ __forceinline__ void load_xrow(const bf16* X, size_t row, int lane, f32x4 (&v)[4]) {
#pragma unroll
    for (int j = 0; j < 4; ++j) { const v2u xv = *(const v2u*)(X + row * DM + 4 * lane + 256 * j); v[j] = (f32x4){bflo(xv.x), bfhi(xv.x), bflo(xv.y), bfhi(xv.y)}; }
}
constexpr int RW_PITCH = 2064;
constexpr int R_GS = 32 * RW_PITCH, R_SH = R_GS + 4096, R_LG = R_SH + 4096, R_RS = R_LG + 128 * 33 * 4, R_END = R_RS + 512;
static_assert(R_END <= LTAB_OFF, "router LDS");
__device__ __forceinline__ void p5a_route(Frame& F, int l, int cslot  ) {
    LAS unsigned* lt = (LAS unsigned*)(F.lds + LTAB_OFF);
    LAS float* gsl = (LAS float*)(F.lds + R_GS); LAS float* shl = (LAS float*)(F.lds + R_SH); LAS float* lgl = (LAS float*)(F.lds + R_LG); LAS float* rsl = (LAS float*)(F.lds + R_RS);
    const int tokb = F.vcu * 128, b = tokb >> 11, fr = F.lane & 15, fq = F.lane >> 4; const bf16* X = wsb(F, WS_X);
    __syncthreads();
    { const v4u* src = (const v4u*)(F.ws + WS_WR);
#pragma unroll
      for (int i = 0; i < 8; ++i) { const int c = F.tid + 512 * i; *(LAS v4u*)(F.lds + (c >> 7) * RW_PITCH + (c & 127) * 16) = src[c]; }
      const float* mod = modp(F, l) + b * 6144;
      for (int k = F.tid; k < DM; k += 512) { gsl[k] = F.inp[I_GN2][l * DM + k] * (mod[4096 + k] + 1.0f); shl[k] = mod[3072 + k]; }
      if (F.tid < 32) lt[LT_CNT + F.tid] = 0u; }
    __syncthreads();
    float myrs = 0.f;
    for (int i = 0; i < 16; i += 4) { f32x4 v0[4], v1[4], v2[4], v3[4];
        load_xrow(X, (size_t)(tokb + 16 * F.wave + i), F.lane, v0); load_xrow(X, (size_t)(tokb + 16 * F.wave + i + 1), F.lane, v1);
        load_xrow(X, (size_t)(tokb + 16 * F.wave + i + 2), F.lane, v2); load_xrow(X, (size_t)(tokb + 16 * F.wave + i + 3), F.lane, v3);
        const float r0 = row_rstd(v0), r1 = row_rstd(v1), r2 = row_rstd(v2), r3 = row_rstd(v3);
        myrs = (fr == i) ? r0 : (fr == i + 1) ? r1 : (fr == i + 2) ? r2 : (fr == i + 3) ? r3 : myrs; }
    if (fq == 0) rsl[16 * F.wave + fr] = myrs;
    f32x4 acc0 = (f32x4){0.f, 0.f, 0.f, 0.f}, acc1 = acc0;
    const bf16* xr = X + (size_t)(tokb + 16 * F.wave + fr) * DM + 8 * fq;
#pragma unroll 4
    for (int ks = 0; ks < 32; ++ks) { const v4u xv = *(const v4u*)(xr + 32 * ks); const int k0 = 32 * ks + 8 * fq;
        const f32x4 g0 = *(const LAS f32x4*)(gsl + k0), g1 = *(const LAS f32x4*)(gsl + k0 + 4), s0 = *(const LAS f32x4*)(shl + k0), s1 = *(const LAS f32x4*)(shl + k0 + 4);
        v4u hv;
        hv.x = pk2(bflo(xv.x) * myrs * g0[0] + s0[0], bfhi(xv.x) * myrs * g0[1] + s0[1]); hv.y = pk2(bflo(xv.y) * myrs * g0[2] + s0[2], bfhi(xv.y) * myrs * g0[3] + s0[3]);
        hv.z = pk2(bflo(xv.z) * myrs * g1[0] + s1[0], bfhi(xv.z) * myrs * g1[1] + s1[1]); hv.w = pk2(bflo(xv.w) * myrs * g1[2] + s1[2], bfhi(xv.w) * myrs * g1[3] + s1[3]);
        if (FP8_ON(l, 2)) *(v2u*)((unsigned char*)(F.ws + WS_H2) + (size_t)(tokb + 16 * F.wave + fr) * DM + k0) = (v2u){pk4f8(bflo(hv.x), bfhi(hv.x), bflo(hv.y), bfhi(hv.y)), pk4f8(bflo(hv.z), bfhi(hv.z), bflo(hv.w), bfhi(hv.w))};
        else *(v4u*)(wsb(F, WS_H2) + (size_t)(tokb + 16 * F.wave + fr) * DM + k0) = hv;
        const bf16x8 a = __builtin_bit_cast(bf16x8, hv);
        acc0 = mma16(a, ldfrag(F.lds, RW_PITCH, 0, 32 * ks, fr, fq), acc0); acc1 = mma16(a, ldfrag(F.lds, RW_PITCH, 16, 32 * ks, fr, fq), acc1); }
    { LAS float* lr = lgl + (16 * F.wave + fr) * 33 + 4 * fq;
      lr[0] = acc0[0]; lr[1] = acc0[1]; lr[2] = acc0[2]; lr[3] = acc0[3]; lr[16] = acc1[0]; lr[17] = acc1[1]; lr[18] = acc1[2]; lr[19] = acc1[3]; }
    __syncthreads();
    if (F.tid < 128) {
        float lg[32]; float mx = -3.0e38f;
#pragma unroll
        for (int e = 0; e < 32; ++e) { lg[e] = lgl[F.tid * 33 + e] + F.inp[I_RB][e]; mx = fmaxf(mx, lg[e]); }
#pragma unroll
        for (int e = 0; e < 32; ++e) lg[e] = __expf(lg[e] - mx);
        float bt1 = 0.f, bt2 = 0.f, bgs = -1.f; int bi1 = 0, bi2 = 0, bg = 0;
#pragma unroll
        for (int g = 0; g < 4; ++g) { float t1 = -1.f, t2 = -1.f; int i1 = 0, i2 = 0;
#pragma unroll
            for (int i = 0; i < 8; ++i) { const float v = lg[8 * g + i];
                if (v > t1) { t2 = t1; i2 = i1; t1 = v; i1 = i; } else if (v > t2) { t2 = v; i2 = i; } }
            const float sc = t1 + t2;
            if (sc > bgs) { bgs = sc; bg = g; bt1 = t1; bt2 = t2; bi1 = i1; bi2 = i2; } }
        const int e0 = 8 * bg + bi1, e1 = 8 * bg + bi2; const float inv = 1.0f / (bt1 + bt2);
        const unsigned r0 = __hip_atomic_fetch_add(&lt[LT_CNT + e0], 1u, __ATOMIC_RELAXED, __HIP_MEMORY_SCOPE_WORKGROUP), r1 = __hip_atomic_fetch_add(&lt[LT_CNT + e1], 1u, __ATOMIC_RELAXED, __HIP_MEMORY_SCOPE_WORKGROUP);
        LAS unsigned* rec = lt + LT_REC + 8 * F.tid;
        rec[0] = (unsigned)(e0 | (e1 << 8)); rec[1] = r0; rec[2] = r1; rec[3] = __float_as_uint(bt1 * inv); rec[4] = __float_as_uint(bt2 * inv); rec[5] = __float_as_uint(rsl[F.tid]);
    }
    __syncthreads();
    if (F.tid < 32) lt[LT_BASE + F.tid] = __hip_atomic_fetch_add((unsigned*)(F.ws + WS_CTL) + CW_CNT + 64 * cslot + F.tid, lt[LT_CNT + F.tid], RLX_AGENT);
    __syncthreads();
    if (F.tid < 128) { const LAS unsigned* rec = lt + LT_REC + 8 * F.tid; const int tok = tokb + F.tid; const unsigned ee = rec[0]; const int e0 = ee & 255, e1 = ee >> 8;
        int* list = (int*)(F.ws + WS_LIST);
        list[e0 * NTOK + (int)(lt[LT_BASE + e0] + rec[1])] = tok; list[e1 * NTOK + (int)(lt[LT_BASE + e1] + rec[2])] = NTOK + tok;
        unsigned* rw = (unsigned*)(F.ws + WS_ROUTE + RT_W); rw[2 * tok] = rec[3]; rw[2 * tok + 1] = rec[4]; }
}
__device__ __forceinline__ void moe_tables(Frame& F, int l) {
    LAS unsigned* lt = (LAS unsigned*)(F.lds + LTAB_OFF);
    __syncthreads();
    if (F.tid < 32) {
        const unsigned cnt = __hip_atomic_load((unsigned*)(F.ws + WS_CTL) + CW_CNT + 64 * l + F.tid, RLX_AGENT), pad = (cnt + 255u) & ~255u;
        unsigned inc = pad;
#pragma unroll
        for (int d = 1; d < 32; d <<= 1) { const unsigned t = __shfl_up(inc, d); if (F.tid >= d) inc += t; }
        const unsigned seg = inc - pad;
        lt[LT_CNT + F.tid] = cnt; lt[LT_SEG + F.tid] = seg; if (F.tid == 31) lt[LT_SEG + 32] = inc;
        for (unsigned t = seg >> 8; t < (inc >> 8); ++t) lt[LT_TILE + t] = (unsigned)F.tid; }
    __syncthreads();
    const int* list = (const int*)(F.ws + WS_LIST); const int ntiles = (int)(lt[LT_SEG + 32] >> 8);
    int rv[3];
#pragma unroll
    for (int q = 0; q < 3; ++q) { const int idx = F.tid + 512 * q, ord = idx >> 8, r = idx & 255, tile = (ord * F.G + F.vcu) >> 2; rv[q] = DUMMY_ROW;
        if (idx < 5 * 256 && tile < ntiles) { const int e = (int)lt[LT_TILE + tile], pos = 256 * (tile - (int)(lt[LT_SEG + e] >> 8)) + r; if (pos < (int)lt[LT_CNT + e]) rv[q] = list[e * NTOK + pos]; } }
#pragma unroll
    for (int q = 0; q < 3; ++q) { const int idx = F.tid + 512 * q; if (idx < 5 * 256) lt[LT_ROW + idx] = (unsigned)rv[q]; }
    __syncthreads();
}
template <bool GATHER_> struct GroupedOrder {
    static constexpr bool GATHER = GATHER_;
    __device__ __forceinline__ unsigned arow(int ord, int row, int K) const { return (lt[LT_ROW + ord * 256 + row] & 32767u) * (unsigned)(K * 2); }
    const LAS unsigned* lt; int vcu, G, bstride;
    __device__ __forceinline__ bool next(int i, pg8::Unit& u) const {
        const int L = i * G + vcu, tile = L >> 2; if (tile >= (int)(lt[LT_SEG + 32] >> 8)) return false;
        u.pm = tile; u.pn = L & 3; u.bo = (int)lt[LT_TILE + tile] * bstride; u.ui = i; return true;
    }
    __device__ __forceinline__ void a_ready(const pg8::Unit&) const {}
    __device__ __forceinline__ void done(const pg8::Unit&) const {}
};
#ifndef DUP_PH
#define DUP_PH (-1)
#endif
#ifndef DUP_N
#define DUP_N 1
#endif
#ifndef DUP_VAR
#define DUP_VAR 0
#endif
struct Args { const float* in[23]; float* out; unsigned char* ws; int ph_lo, ph_hi; };
__global__ void __launch_bounds__(NWAVES * 64, 2) mk_fwd(Args args) {
    extern __shared__ __attribute__((aligned(16))) unsigned char lds[];
    Frame F;
    F.lds = (LAS unsigned char*)lds;
    F.tid = threadIdx.x; F.lane = F.tid & 63; F.wave = __builtin_amdgcn_readfirstlane(F.tid >> 6);
    int wave0 = F.wave; asm volatile("" : "+s"(wave0));
    F.G = gridDim.x; { const int bx = blockIdx.x; F.vcu = (F.G % 8 == 0) ? (bx % 8) * (F.G / 8) + bx / 8 : bx; }
    F.inp = (KArgPtr)__builtin_amdgcn_kernarg_segment_ptr();
    F.out = args.out; F.ws = args.ws;
    volatile LAS unsigned* MISC = (volatile LAS unsigned*)(F.lds + LDSCTL_OFF);
    for (int u = F.tid; u < (LDS_BYTES - LDSCTL_OFF) / 4; u += NWAVES * 64) MISC[u] = 0u;
    __syncthreads();
    const int lo = args.ph_lo, hi = args.ph_hi;
    XcdBarrier bar; bar.bar = (unsigned*)(F.ws + WS_CTL) + CW_BAR; bar.x = 0; bar.st = nullptr;
    if (hi - lo > 1) bar = xcd_barrier_post((unsigned*)(F.ws + WS_CTL) + CW_BAR, MISC + 8);
#ifdef P0_EXTRA
    for (int q = 0; q < P0_EXTRA; ++q) { p0_prologue(F, P0_VAR); xcd_barrier(bar, F.tid == 0); }
#endif
    for (int ph = lo; ph < hi; ++ph) {
        int w0 = wave0; unsigned ones = ~0u; asm volatile("" : "+s"(w0), "+s"(ones));
        int tid = w0 * 64 + (int)__builtin_amdgcn_mbcnt_hi(ones, __builtin_amdgcn_mbcnt_lo(ones, 0u)); asm volatile("" : "+v"(tid));
        { KArgPtr kp = (KArgPtr)__builtin_amdgcn_kernarg_segment_ptr(); asm volatile("" : "+s"(kp)); F.inp = kp; }
        F.tid = tid; F.lane = tid & 63; F.wave = __builtin_amdgcn_readfirstlane(tid >> 6);
        const int pe = (DUP_PH >= 0 && ph > DUP_PH) ? ((ph - DUP_N > DUP_PH) ? ph - DUP_N : DUP_PH) : ph;
        const int l = (pe >= 2) ? (pe - 2) / 9 : 0, kind = (pe >= 2) ? 2 + (pe - 2) % 9 : pe;
        if (kind == 0) p0_prologue(F, 0);
        else if (kind == 1) p1_first_norm(F);
        else if (kind == 2) {
            pg8::Gemm g{wsb(F, WS_HY), wsb(F, WS_WIN) + (size_t)l * PNP * DM, NTOK, PNP, DM}; pg8::StaticOrder S; S.init(NTOK, PNP, F.G, (int)blockIdx.x);
            pg8::EpiInProj E{wsb(F, WS_P), PNP, nullptr, 0.f};
            if (I8_ON(l)) { pg8::Gemm g8{h8p(F), wsb(F, WS_WIN) + (size_t)l * PNP * DM, NTOK, PNP, DM / 2}; pg8::EpiInProj Ei{wsb(F, WS_P), PNP, hsp(F), 1.0f / WI8S};
                pg8::gemm_phase<pg8::EpiInProj, pg8::StaticOrder, true, true, 0, 0, true>(F.lds, g8, S, Ei, tid); }
            else if (FP8_ON(l, 0)) { pg8::Gemm g8{h8p(F), wsb(F, WS_WIN) + (size_t)l * PNP * DM, NTOK, PNP, DM / 2}; pg8::gemm_phase<pg8::EpiInProj, pg8::StaticOrder, false, true, E8_ONE, E8_W>(F.lds, g8, S, E, tid); }
            else pg8::gemm_phase<pg8::EpiInProj, pg8::StaticOrder, true, true>(F.lds, g, S, E, tid); }
        else if (kind == 3) p3p_gla_prep(F, l);
        else if (kind == 4) p3a_gla_state(F, l, (DUP_PH >= 0 && ph >= DUP_PH && ph < DUP_PH + DUP_N) ? DUP_VAR : 0);
        else if (kind == 5) p3c_mixer_out(F, l);
        else if (kind == 6) {
            pg8::Gemm g{wsb(F, WS_HY), wsb(F, WS_WOUT) + (size_t)l * DM * DM, NTOK, DM, DM}; pg8::StaticOrder S; S.init(NTOK, DM, F.G, (int)blockIdx.x);
            const bool dry = (DUP_PH >= 0 && ph >= DUP_PH && ph < DUP_PH + DUP_N);
            pg8::EpiResid E{wsb(F, WS_X), modp(F, l) + 2048, dry ? wsb(F, WS_P) : wsb(F, WS_X)};
            if (FP8_ON(l, 1)) { pg8::Gemm g8{wsb(F, WS_HY), wsb(F, WS_WOUT) + (size_t)l * DM * DM, NTOK, DM, DM / 2}; pg8::gemm_phase<pg8::EpiResid, pg8::StaticOrder, true, true, E8_Y, E8_W>(F.lds, g8, S, E, tid); }
            else pg8::gemm_phase<pg8::EpiResid, pg8::StaticOrder, true, true>(F.lds, g, S, E, tid); }
        else if (kind == 7) p5a_route(F, l, (DUP_PH >= 0 && ph > DUP_PH && ph <= DUP_PH + DUP_N) ? l + 2 : l);
        else if (kind == 8) {
            moe_tables(F, l);
            pg8::Gemm g{wsb(F, WS_H2), wsb(F, WS_W13) + (size_t)l * NEXP * DM * DM, MAXSLOT, DM, DM};
            GroupedOrder<true> S{(const LAS unsigned*)(F.lds + LTAB_OFF), F.vcu, F.G, DM * DM};
            pg8::Gemm g8{wsb(F, WS_H2), wsb(F, WS_W13) + (size_t)l * NEXP * DM * DM, MAXSLOT, DM, DM / 2};
            pg8::EpiSwiGLU8 E8{F.ws + WS_HID, H8S}; pg8::EpiSwiGLU E{wsb(F, WS_HID)};
            if (FP8_ON(l, 2)) { if (FP8_ON(l, 3)) pg8::gemm_phase<pg8::EpiSwiGLU8, GroupedOrder<true>, true, true, E8_ONE, E8_W>(F.lds, g8, S, E8, tid);
                                else pg8::gemm_phase<pg8::EpiSwiGLU, GroupedOrder<true>, true, true, E8_ONE, E8_W>(F.lds, g8, S, E, tid); }
            else { if (FP8_ON(l, 3)) pg8::gemm_phase<pg8::EpiSwiGLU8, GroupedOrder<true>, true, true>(F.lds, g, S, E8, tid);
                   else pg8::gemm_phase<pg8::EpiSwiGLU, GroupedOrder<true>, true, true>(F.lds, g, S, E, tid); } }
        else if (kind == 9) {
            pg8::Gemm g{wsb(F, WS_HID), wsb(F, WS_W2) + (size_t)l * NEXP * DM * DFF, MAXSLOT, DM, DFF};
            GroupedOrder<false> S{(const LAS unsigned*)(F.lds + LTAB_OFF), F.vcu, F.G, DM * DFF};
#if YE_FP8
            typedef pg8::EpiScatter8 EpiY; EpiY E{F.ws + WS_YE, (const LAS int*)(F.lds + LTAB_OFF) + LT_ROW, E8S};
#else
            typedef pg8::EpiScatter EpiY; EpiY E{wsb(F, WS_YE), (const LAS int*)(F.lds + LTAB_OFF) + LT_ROW};
#endif
            if (FP8_ON(l, 3)) { pg8::Gemm g8{wsb(F, WS_HID), wsb(F, WS_W2) + (size_t)l * NEXP * DM * DFF, MAXSLOT, DM, DFF / 2};
                pg8::gemm_phase<EpiY, GroupedOrder<false>, true, true, E8_H, E8_W>(F.lds, g8, S, E, tid); }
            else pg8::gemm_phase<EpiY, GroupedOrder<false>, true, true>(F.lds, g, S, E, tid); }
        else p9_combine(F, l, (DUP_PH >= 0 && ph >= DUP_PH && ph < DUP_PH + DUP_N));
        if (ph + 1 < hi) xcd_barrier(bar, tid == 0);
    }
}

extern "C" void kernel_launch(void* const* d_in, const int* in_sizes, int n_in, void* d_out, int out_size, void* d_ws, size_t ws_size, hipStream_t stream) {
    static int grid = 0;
    if (grid == 0) {
        if (n_in != 23 || in_sizes[0] != NTOK * DM || out_size != NTOK * DM || ws_size < WS_END) {
            fprintf(stderr, "kernel_launch: unexpected problem (n_in %d, in0 %d, out %d, ws %zu; need ws >= %zu); nothing launched\n", n_in, n_in > 0 ? in_sizes[0] : -1, out_size, ws_size, (size_t)WS_END); grid = -1; return; }
        int dev = 0, cus = 0, per_cu = 0;
        if (hipGetDevice(&dev) != hipSuccess || hipDeviceGetAttribute(&cus, hipDeviceAttributeMultiprocessorCount, dev) != hipSuccess) { grid = -1; return; }
        if (hipFuncSetAttribute((const void*)mk_fwd, hipFuncAttributeMaxDynamicSharedMemorySize, LDS_BYTES) != hipSuccess) { fprintf(stderr, "kernel_launch: hipFuncSetAttribute failed\n"); grid = -1; return; }
        if (hipOccupancyMaxActiveBlocksPerMultiprocessor(&per_cu, (const void*)mk_fwd, NWAVES * 64, LDS_BYTES) != hipSuccess || per_cu < 1)
            fprintf(stderr, "kernel_launch: note: occupancy query reports %d workgroups per CU\n", per_cu);
        (void)hipGetLastError();
        grid = cus;
        if (grid != 256) fprintf(stderr, "kernel_launch: %d CUs; the phase bodies assume 256 workgroups\n", grid);
    }
    if (grid < 0) return;
    if (hipMemsetAsync((char*)d_ws + WS_CTL, 0, CTL_ZERO_BYTES, stream) != hipSuccess) { fprintf(stderr, "kernel_launch: memset failed\n"); return; }
    Args a{};
    for (int i = 0; i < 23; ++i) a.in[i] = (const float*)d_in[i];
    a.out = (float*)d_out; a.ws = (unsigned char*)d_ws;
    if (MK_N_LAUNCHES == 1) { a.ph_lo = 0; a.ph_hi = NPHASES + (DUP_PH >= 0 ? DUP_N : 0); hipLaunchKernelGGL(mk_fwd, dim3(grid), dim3(NWAVES * 64), LDS_BYTES, stream, a); }
    else for (int p = 0; p < NPHASES; ++p) { a.ph_lo = p; a.ph_hi = p + 1; hipLaunchKernelGGL(mk_fwd, dim3(grid), dim3(NWAVES * 64), LDS_BYTES, stream, a); }
    const hipError_t le = hipPeekAtLastError();
    if (le != hipSuccess) fprintf(stderr, "kernel_launch: launch failed: %s\n", hipGetErrorName(le));
}
```

```cpp
#include <hip/hip_runtime.h>
#include <cstdio>
#include <cstdint>
namespace pg8 {
#define PG8_LAS __attribute__((address_space(3)))
typedef unsigned short bf16_t;
typedef short bf16x8 __attribute__((ext_vector_type(8)));
typedef float f32x4 __attribute__((ext_vector_type(4)));
typedef unsigned u32x4 __attribute__((ext_vector_type(4)));
typedef int pg8_v4i __attribute__((ext_vector_type(4)));
typedef int pg8_v8i __attribute__((ext_vector_type(8)));
constexpr int BM = 256, BK = 64, HALF = 128, HTB = HALF * BK * 2  , STAGE_BYTES = 8 * HTB, NXCD = 8, WGM = 8;

__host__ __device__ __forceinline__ int lds_byte(int r, int c) { const int st = (r >> 4) * 2 + (c >> 5), rr = r & 15, cc = c & 31, ob = rr * 64 + cc * 2; return st * 1024 + (ob ^ (((ob >> 9) & 1) << 5)); }
__host__ __device__ __forceinline__ void stage_rc(int b, int& R, int& C) { const int st = b / 1024, sb = b % 1024, swz = sb ^ (((sb >> 9) & 1) << 5); R = (st >> 1) * 16 + swz / 64; C = (st & 1) * 32 + (swz % 64) / 2; }
__host__ __device__ __forceinline__ int perm32(int rho) { const int n = rho >> 4, i = rho & 15; return 8 * (i >> 2) + 4 * n + (i & 3); }

struct Unit { int pm, pn, bo, ui; };
struct Gemm { const bf16_t* A; const bf16_t* Bt; int M, N, K; };

struct StaticOrder {
    static constexpr bool GATHER = false;
    __device__ __forceinline__ unsigned arow(int, int, int) const { return 0u; }
    int nM, nN, nwg, G, c, rot = 0;
    __host__ __device__ void init(int M, int N, int G_, int c_) { nM = M / BM; nN = N / BM; nwg = nM * nN; G = G_; c = c_; }
    __host__ __device__ bool next(int i, Unit& u) const {
        const long L = (long)i * G + c; if (L >= nwg) return false;
        int wgid = (int)L; { const int q = nwg / NXCD, r = nwg % NXCD, xcd = wgid % NXCD, off = wgid / NXCD; wgid = (xcd < r ? xcd * (q + 1) : r * (q + 1) + (xcd - r) * q) + off; }
        const int nig = WGM * nN, gid = wgid / nig, fm = gid * WGM, gsz = (nM - fm) < WGM ? (nM - fm) : WGM;
        u.pm = fm + ((wgid % nig) % gsz); u.pn = (wgid % nig) / gsz; u.bo = 0; u.ui = i; return true;
    }
    __device__ __forceinline__ void a_ready(const Unit&) const {}
    __device__ __forceinline__ void done(const Unit&) const {}
};

__device__ __forceinline__ unsigned cvt_pk_bf16(float lo, float hi) { unsigned r; asm volatile("v_cvt_pk_bf16_f32 %0, %1, %2" : "=v"(r) : "v"(lo), "v"(hi)); return r; }
typedef float f32x2 __attribute__((ext_vector_type(2)));
__device__ __forceinline__ f32x2 gelu_pk(f32x2 v) {
    const f32x2 av = __builtin_elementwise_abs(v), d = av * 0.2316418882f + 1.0f;
    f32x2 t; t.x = __builtin_amdgcn_rcpf(d.x); t.y = __builtin_amdgcn_rcpf(d.y);
    f32x2 q = t * 0.5307027145f + (-0.7265760135f); q = q * t + 0.7107068705f; q = q * t + (-0.142248368f); q = q * t + 0.127414796f; q = q * t;
    const f32x2 s = (v * v) * (-0.72134752044f);
    f32x2 e; e.x = __builtin_amdgcn_exp2f(s.x); e.y = __builtin_amdgcn_exp2f(s.y);
    const f32x2 m = v * (q * e), r = v - m;
    f32x2 o; o.x = v.x < 0.f ? m.x : r.x; o.y = v.y < 0.f ? m.y : r.y; return o;
}

__device__ __forceinline__ float bf_lo(unsigned w) { return __uint_as_float(w << 16); }
__device__ __forceinline__ float bf_hi(unsigned w) { return __uint_as_float(w & 0xffff0000u); }
__device__ __forceinline__ float silu_f(float a) { return a * __builtin_amdgcn_rcpf(1.0f + __expf(-a)); }

struct EpiInProj {
    static constexpr bool PERM = true, AFTER_DRAIN = false;
    static constexpr int NVM = 16;
    static constexpr bool ALWAYS_FULL = false;
    __device__ __forceinline__ bool full(const Unit& u) const { return u.pn != 11; }
    bf16_t* O; int ldc; const float* rs; float ws;
    __device__ __forceinline__ void operator()(const f32x4 (&acc)[2][2][4][2], const Unit& u, int wr, int wc, int fr, int fq) const {
        asm volatile("" : "+v"(fr), "+v"(fq));
        const int row0 = u.pm * BM + wr * 64 + fr, col0 = u.pn * BM + wc * 32 + 8 * fq;
        const bool act = u.pn < 2, last_tile = u.pn == 11;
        float dqv[8];
#pragma unroll
        for (int q = 0; q < 8; ++q) dqv[q] = rs ? rs[row0 + (q >> 2) * HALF + (q & 3) * 16] * ws : 0.f;
#pragma unroll
        for (int ai = 0; ai < 2; ++ai)
#pragma unroll
            for (int m = 0; m < 4; ++m) { bf16_t* rowp = O + (size_t)(row0 + ai * HALF + m * 16) * ldc + col0; const float dq = dqv[ai * 4 + m];
#pragma unroll
                for (int bj = 0; bj < 2; ++bj) { f32x4 v0 = acc[ai][bj][m][0], v1 = acc[ai][bj][m][1];
                    if (rs) { const pg8_v4i i0 = __builtin_bit_cast(pg8_v4i, v0), i1 = __builtin_bit_cast(pg8_v4i, v1);
                        v0 = (f32x4){(float)i0[0], (float)i0[1], (float)i0[2], (float)i0[3]} * dq; v1 = (f32x4){(float)i1[0], (float)i1[1], (float)i1[2], (float)i1[3]} * dq; }
                    if (last_tile && (bj != 0 || wc != 0 || fq >= 2)) continue;
                    if (act) { f32x2 a = gelu_pk((f32x2){v0[0], v0[1]}), b = gelu_pk((f32x2){v0[2], v0[3]}), c = gelu_pk((f32x2){v1[0], v1[1]}), d = gelu_pk((f32x2){v1[2], v1[3]});
                        v0 = (f32x4){a.x, a.y, b.x, b.y}; v1 = (f32x4){c.x, c.y, d.x, d.y}; }
                    u32x4 w; w.x = cvt_pk_bf16(v0[0], v0[1]); w.y = cvt_pk_bf16(v0[2], v0[3]); w.z = cvt_pk_bf16(v1[0], v1[1]); w.w = cvt_pk_bf16(v1[2], v1[3]);
                    *(u32x4*)(rowp + bj * HALF) = w; } }
    }
};

struct EpiResid {
    static constexpr bool PERM = true, AFTER_DRAIN = false;
    static constexpr int NVM = 32;
    static constexpr bool ALWAYS_FULL = true;
    __device__ __forceinline__ bool full(const Unit& u) const { return true; }
    bf16_t* X; const float* gt; bf16_t* Xo;
    __device__ __forceinline__ void operator()(const f32x4 (&acc)[2][2][4][2], const Unit& u, int wr, int wc, int fr, int fq) const {
        asm volatile("" : "+v"(fr), "+v"(fq));
        const int row0 = u.pm * BM + wr * 64 + fr, col0 = u.pn * BM + wc * 32 + 8 * fq;
        const float* gp = gt + (size_t)(u.pm >> 3) * 6144 + col0;
#pragma unroll
        for (int bj = 0; bj < 2; ++bj) { const f32x4 g0 = *(const f32x4*)(gp + bj * HALF), g1 = *(const f32x4*)(gp + bj * HALF + 4);
        u32x4 xq[8];
#pragma unroll
        for (int q = 0; q < 8; ++q) xq[q] = *(const u32x4*)(X + (size_t)(row0 + (q >> 2) * HALF + (q & 3) * 16) * 1024 + col0 + bj * HALF);
        asm volatile("" ::: "memory");
#pragma unroll
        for (int ai = 0; ai < 2; ++ai)
#pragma unroll
            for (int m = 0; m < 4; ++m) { bf16_t* rowp = X + (size_t)(row0 + ai * HALF + m * 16) * 1024 + col0;
                const u32x4 xv = xq[ai * 4 + m];
                const f32x4 a0 = acc[ai][bj][m][0], a1 = acc[ai][bj][m][1];
                u32x4 w;
                w.x = cvt_pk_bf16(bf_lo(xv.x) + g0[0] * a0[0], bf_hi(xv.x) + g0[1] * a0[1]);
                w.y = cvt_pk_bf16(bf_lo(xv.y) + g0[2] * a0[2], bf_hi(xv.y) + g0[3] * a0[3]);
                w.z = cvt_pk_bf16(bf_lo(xv.z) + g1[0] * a1[0], bf_hi(xv.z) + g1[1] * a1[1]);
                w.w = cvt_pk_bf16(bf_lo(xv.w) + g1[2] * a1[2], bf_hi(xv.w) + g1[3] * a1[3]);
                *(u32x4*)(Xo + (rowp - X) + bj * HALF) = w; } }
    }
};

struct EpiSwiGLU {
    static constexpr bool PERM = true, AFTER_DRAIN = false;
    static constexpr int NVM = 8;
    static constexpr bool ALWAYS_FULL = true;
    __device__ __forceinline__ bool full(const Unit& u) const { return true; }
    bf16_t* O;
    __device__ __forceinline__ void operator()(const f32x4 (&acc)[2][2][4][2], const Unit& u, int wr, int wc, int fr, int fq) const {
        asm volatile("" : "+v"(fr), "+v"(fq));
        const int row0 = u.pm * BM + wr * 64 + fr, col0 = u.pn * HALF + wc * 32 + 8 * fq;
#pragma unroll
        for (int ai = 0; ai < 2; ++ai)
#pragma unroll
            for (int m = 0; m < 4; ++m) { bf16_t* rowp = O + (size_t)(row0 + ai * HALF + m * 16) * 512 + col0;
                const f32x4 a0 = acc[ai][0][m][0], a1 = acc[ai][0][m][1], b0 = acc[ai][1][m][0], b1 = acc[ai][1][m][1];
                u32x4 w;
                w.x = cvt_pk_bf16(silu_f(a0[0]) * b0[0], silu_f(a0[1]) * b0[1]); w.y = cvt_pk_bf16(silu_f(a0[2]) * b0[2], silu_f(a0[3]) * b0[3]);
                w.z = cvt_pk_bf16(silu_f(a1[0]) * b1[0], silu_f(a1[1]) * b1[1]); w.w = cvt_pk_bf16(silu_f(a1[2]) * b1[2], silu_f(a1[3]) * b1[3]);
                *(u32x4*)rowp = w; }
    }
};

__device__ __forceinline__ unsigned pk4_fp8(float a, float b, float c, float d) {
    a = __builtin_amdgcn_fmed3f(a, -448.f, 448.f); b = __builtin_amdgcn_fmed3f(b, -448.f, 448.f); c = __builtin_amdgcn_fmed3f(c, -448.f, 448.f); d = __builtin_amdgcn_fmed3f(d, -448.f, 448.f);
    unsigned w = 0u; w = (unsigned)__builtin_amdgcn_cvt_pk_fp8_f32(a, b, (int)w, false); w = (unsigned)__builtin_amdgcn_cvt_pk_fp8_f32(c, d, (int)w, true); return w;
}
struct EpiSwiGLU8 {
    static constexpr bool PERM = true, AFTER_DRAIN = false;
    static constexpr int NVM = 8;
    static constexpr bool ALWAYS_FULL = true;
    __device__ __forceinline__ bool full(const Unit& u) const { return true; }
    unsigned char* O; float SC;
    __device__ __forceinline__ void operator()(const f32x4 (&acc)[2][2][4][2], const Unit& u, int wr, int wc, int fr, int fq) const {
        asm volatile("" : "+v"(fr), "+v"(fq));
        const int row0 = u.pm * BM + wr * 64 + fr, col0 = u.pn * HALF + wc * 32 + 8 * fq;
#pragma unroll
        for (int ai = 0; ai < 2; ++ai)
#pragma unroll
            for (int m = 0; m < 4; ++m) { unsigned char* rowp = O + (size_t)(row0 + ai * HALF + m * 16) * 512 + col0;
                const f32x4 a0 = acc[ai][0][m][0], a1 = acc[ai][0][m][1], b0 = acc[ai][1][m][0] * SC, b1 = acc[ai][1][m][1] * SC;
                typedef unsigned u32x2 __attribute__((ext_vector_type(2)));
                u32x2 w; w.x = pk4_fp8(silu_f(a0[0]) * b0[0], silu_f(a0[1]) * b0[1], silu_f(a0[2]) * b0[2], silu_f(a0[3]) * b0[3]);
                w.y = pk4_fp8(silu_f(a1[0]) * b1[0], silu_f(a1[1]) * b1[1], silu_f(a1[2]) * b1[2], silu_f(a1[3]) * b1[3]);
                *(u32x2*)rowp = w; }
    }
};

struct EpiScatter8 {
    static constexpr bool PERM = true, AFTER_DRAIN = false;
    static constexpr int NVM = 16;
    static constexpr bool ALWAYS_FULL = true;
    __device__ __forceinline__ bool full(const Unit& u) const { return true; }
    unsigned char* O; const PG8_LAS int* rowtab; float SC;
    __device__ __forceinline__ void operator()(const f32x4 (&acc)[2][2][4][2], const Unit& u, int wr, int wc, int fr, int fq) const {
        asm volatile("" : "+v"(fr), "+v"(fq));
        const int col0 = u.pn * BM + wc * 32 + 8 * fq;
        typedef unsigned u32x2 __attribute__((ext_vector_type(2)));
#pragma unroll
        for (int ai = 0; ai < 2; ++ai)
#pragma unroll
            for (int m = 0; m < 4; ++m) { const int d = rowtab[u.ui * BM + wr * 64 + fr + ai * HALF + m * 16]; unsigned char* rowp = O + (size_t)d * 1024 + col0;
#pragma unroll
                for (int bj = 0; bj < 2; ++bj) { const f32x4 v0 = acc[ai][bj][m][0] * SC, v1 = acc[ai][bj][m][1] * SC;
                    *(u32x2*)(rowp + bj * HALF) = (u32x2){pk4_fp8(v0[0], v0[1], v0[2], v0[3]), pk4_fp8(v1[0], v1[1], v1[2], v1[3])}; } }
    }
};

struct EpiScatter {
    static constexpr bool PERM = true, AFTER_DRAIN = false;
    static constexpr int NVM = 16;
    static constexpr bool ALWAYS_FULL = true;
    __device__ __forceinline__ bool full(const Unit& u) const { return true; }
    bf16_t* O; const PG8_LAS int* rowtab;
    __device__ __forceinline__ void operator()(const f32x4 (&acc)[2][2][4][2], const Unit& u, int wr, int wc, int fr, int fq) const {
        asm volatile("" : "+v"(fr), "+v"(fq));
        const int row0 = u.pm * BM + wr * 64 + fr, col0 = u.pn * BM + wc * 32 + 8 * fq;
#pragma unroll
        for (int ai = 0; ai < 2; ++ai)
#pragma unroll
            for (int m = 0; m < 4; ++m) { const int d = rowtab[u.ui * BM + wr * 64 + fr + ai * HALF + m * 16]; bf16_t* rowp = O + (size_t)d * 1024 + col0;
#pragma unroll
                for (int bj = 0; bj < 2; ++bj) { const f32x4 v0 = acc[ai][bj][m][0], v1 = acc[ai][bj][m][1];
                    u32x4 w; w.x = cvt_pk_bf16(v0[0], v0[1]); w.y = cvt_pk_bf16(v0[2], v0[3]); w.z = cvt_pk_bf16(v1[0], v1[1]); w.w = cvt_pk_bf16(v1[2], v1[3]);
                    *(u32x4*)(rowp + bj * HALF) = w; } }
    }
};

template <class Epi, class Sched, bool ALIGN_EPI = false, bool SP2 = false, int FP8SA = 0, int FP8SB = 0, bool I8 = false>
__device__ __forceinline__ void gemm_phase(PG8_LAS unsigned char* lds, const Gemm g, const Sched& S, const Epi& E, const int tid) {
    const int wid = __builtin_amdgcn_readfirstlane(tid >> 6), lane = tid & 63, wr = wid >> 2, wc = wid & 3, fr = lane & 15, fq = lane >> 4;
    const int K = g.K, nt = K / BK;
    unsigned voffA[2], voffB[2];
    unsigned ga[2][2], gn[2][2];
#pragma unroll
    for (int i = 0; i < 2; ++i) { int R, C; stage_rc(tid * 16 + i * 8192, R, C); const int Rb = Epi::PERM ? ((R & ~31) + perm32(R & 31)) : R;
        voffA[i] = (unsigned)(R * K + C) * 2u; voffB[i] = (unsigned)(Rb * K + C) * 2u; }
    const size_t kstep = (size_t)(BK * 2);
    const size_t hstep = (size_t)HALF * K * 2;
    const size_t tstep = 2 * hstep;
    const unsigned ldsw = (unsigned)wid * 1024u;
    const int aoff = lds_byte(wr * 64 + fr, fq * 8), boff = lds_byte(wc * 32 + fr, fq * 8);
#define PG8_SA(b, h) (((b) * 2 + (h)) * HTB)
#define PG8_SB(b, h) ((4 + (b) * 2 + (h)) * HTB)
#define PG8_STAGE(bufoff, gbase, voff) do { _Pragma("unroll") for (int _i = 0; _i < 2; ++_i) \
        __builtin_amdgcn_global_load_lds((const unsigned*)((const char*)(gbase) + (voff)[_i]), (PG8_LAS unsigned*)(lds + (bufoff) + ldsw + _i * 8192), 16, 0, 0); } while (0)
#define PG8_STAGE_A(bufoff, ptr, h, nx, kb) do { if constexpr (Sched::GATHER) { _Pragma("unroll") for (int _i = 0; _i < 2; ++_i) { const unsigned _o = ((nx) ? gn[h][_i] : ga[h][_i]) + (unsigned)(kb); \
        __builtin_amdgcn_global_load_lds((const unsigned*)((const char*)g.A + _o), (PG8_LAS unsigned*)(lds + (bufoff) + ldsw + _i * 8192), 16, 0, 0); } } else { PG8_STAGE(bufoff, ptr, voffA); } } while (0)
#define PG8_GOFF(dst, ord) do { if constexpr (Sched::GATHER) { _Pragma("unroll") for (int _i = 0; _i < 2; ++_i) { int _R, _C; stage_rc(tid * 16 + _i * 8192, _R, _C);   \
        _Pragma("unroll") for (int _h = 0; _h < 2; ++_h) dst[_h][_i] = S.arow((ord), 128 * _h + _R, K) + (unsigned)_C * 2u; } } } while (0)
#define PG8_LD8(p) __builtin_shufflevector(*(const PG8_LAS pg8_v4i*)(p), *(const PG8_LAS pg8_v4i*)((p) + 1024), 0, 1, 2, 3, 4, 5, 6, 7)
#define PG8_LDA(dst, b, h) do { if constexpr (FP8SA != 0) { _Pragma("unroll") for (int m = 0; m < 4; ++m) dst##8[m] = PG8_LD8(lds + PG8_SA(b, h) + aoff + m * 2048); } \
        else { _Pragma("unroll") for (int m = 0; m < 4; ++m) _Pragma("unroll") for (int k = 0; k < 2; ++k) dst[m][k] = *(const PG8_LAS bf16x8*)(lds + PG8_SA(b, h) + aoff + m * 2048 + k * 1024); } } while (0)
#define PG8_LDB(dst, b, h) do { if constexpr (FP8SA != 0) { _Pragma("unroll") for (int n = 0; n < 2; ++n) dst##8[n] = PG8_LD8(lds + PG8_SB(b, h) + boff + n * 2048); } \
        else { _Pragma("unroll") for (int n = 0; n < 2; ++n) _Pragma("unroll") for (int k = 0; k < 2; ++k) dst[n][k] = *(const PG8_LAS bf16x8*)(lds + PG8_SB(b, h) + boff + n * 2048 + k * 1024); } } while (0)
#define PG8_MMA(ai, bj, At, Bt) do { __builtin_amdgcn_s_setprio(1); _Pragma("unroll") for (int m = 0; m < 4; ++m) _Pragma("unroll") for (int n = 0; n < 2; ++n) { \
        if constexpr (FP8SA != 0) asm volatile("v_mfma_scale_f32_16x16x128_f8f6f4 %0, %1, %2, %0, %3, %4 op_sel_hi:[0,0,0]" : "+v"(acc[ai][bj][m][n]) : "v"(Bt##8[n]), "v"(At##8[m]), "v"(sc8b), "v"(sc8a));   \
        else if constexpr (I8) { _Pragma("unroll") for (int k = 0; k < 2; ++k) acc[ai][bj][m][n] = __builtin_bit_cast(f32x4, __builtin_amdgcn_mfma_i32_16x16x64_i8(__builtin_bit_cast(pg8_v4i, Bt[n][k]), __builtin_bit_cast(pg8_v4i, At[m][k]), __builtin_bit_cast(pg8_v4i, acc[ai][bj][m][n]), 0, 0, 0)); } \
        else { _Pragma("unroll") for (int k = 0; k < 2; ++k) acc[ai][bj][m][n] = __builtin_amdgcn_mfma_f32_16x16x32_bf16(Bt[n][k], At[m][k], acc[ai][bj][m][n], 0, 0, 0); } } __builtin_amdgcn_s_setprio(0); } while (0)
#define PG8_WAIT_V(n) asm volatile("s_waitcnt vmcnt(" #n ")" ::: "memory")
#define PG8_WAIT_VN(n) asm volatile("s_waitcnt vmcnt(%0)" :: "n"(n) : "memory")
#define PG8_WAIT_VR(rl) do { if (rl) PG8_WAIT_VN(8 + Epi::NVM); else PG8_WAIT_V(8); } while (0)
#define PG8_WAIT_L(n) asm volatile("s_waitcnt lgkmcnt(" #n ")" ::: "memory")
#define PG8_BAR __builtin_amdgcn_s_barrier()
#define PG8_SCHED __builtin_amdgcn_sched_barrier(0)
    Unit cur, nxt; int ui = 0;
    if (!S.next(0, cur)) return;
    f32x4 acc[2][2][4][2];
#pragma unroll
    for (int a = 0; a < 2; ++a)
#pragma unroll
        for (int b = 0; b < 2; ++b)
#pragma unroll
            for (int m = 0; m < 4; ++m)
#pragma unroll
                for (int n = 0; n < 2; ++n) acc[a][b][m][n] = (f32x4){0.f, 0.f, 0.f, 0.f};
    bf16x8 At[4][2], B0[2][2], B1[2][2];
    pg8_v8i At8[4], B08[2], B18[2];
    const int sc8a = FP8SA * 0x01010101, sc8b = FP8SB * 0x01010101;
    const char* cA = (const char*)g.A + (size_t)cur.pm * tstep; const char* cB = (const char*)g.Bt + (size_t)cur.bo * 2 + (size_t)cur.pn * tstep;
    S.a_ready(cur);
    PG8_GOFF(ga, 0); PG8_GOFF(gn, 0);
    if constexpr (SP2) {
        PG8_STAGE(PG8_SB(0, 0), cB, voffB); PG8_STAGE(PG8_SB(0, 1), cB + hstep, voffB); PG8_STAGE_A(PG8_SA(0, 0), cA, 0, false, 0); PG8_STAGE_A(PG8_SA(0, 1), cA + hstep, 1, false, 0);
        if (wr == 1) PG8_BAR;
        PG8_WAIT_V(2); PG8_BAR;
        PG8_STAGE(PG8_SB(1, 0), cB + kstep, voffB); PG8_STAGE_A(PG8_SA(1, 0), cA + kstep, 0, false, kstep); PG8_STAGE(PG8_SB(1, 1), cB + hstep + kstep, voffB);
        PG8_WAIT_V(6); PG8_BAR;
    } else {
        PG8_STAGE(PG8_SB(0, 0), cB, voffB); PG8_STAGE(PG8_SA(0, 0), cA, voffA); PG8_STAGE(PG8_SB(0, 1), cB + hstep, voffB); PG8_STAGE(PG8_SA(0, 1), cA + hstep, voffA);
        if (wr == 1) PG8_BAR;
        PG8_WAIT_V(4); PG8_BAR;
        PG8_STAGE(PG8_SB(1, 0), cB + kstep, voffB); PG8_STAGE(PG8_SA(1, 0), cA + kstep, voffA); PG8_STAGE(PG8_SB(1, 1), cB + hstep + kstep, voffB);
        PG8_WAIT_V(6); PG8_BAR;
    }
    bool relax = false;
    for (;;) {
        const bool has_next = S.next(ui + 1, nxt);
        if constexpr (Sched::GATHER) { if (has_next) PG8_GOFF(gn, ui + 1); else { _Pragma("unroll") for (int _h = 0; _h < 2; ++_h) _Pragma("unroll") for (int _i = 0; _i < 2; ++_i) gn[_h][_i] = ga[_h][_i]; } }
        const char* nA = has_next ? (const char*)g.A + (size_t)nxt.pm * tstep : cA; const char* nB = has_next ? (const char*)g.Bt + (size_t)nxt.bo * 2 + (size_t)nxt.pn * tstep : cB;
#pragma nounroll
        for (int t = 0; t < nt; t += 2) {
            const bool last = (t == nt - 2);
            const char* a1 = cA + (size_t)(t + 1) * kstep;
            const char* a2 = last ? nA : cA + (size_t)(t + 2) * kstep; const char* b2 = last ? nB : cB + (size_t)(t + 2) * kstep;
            const char* a3 = a2 + kstep; const char* b3 = b2 + kstep;
            const size_t kb1 = (size_t)(t + 1) * kstep, kb2 = last ? 0 : (size_t)(t + 2) * kstep, kb3 = kb2 + kstep;
            if (last && has_next) S.a_ready(nxt);
            if constexpr (SP2) {
            const bool rl = Epi::ALWAYS_FULL ? (ui > 0 && t == 0) : (relax && t == 0);
            PG8_LDB(B0, 0, 0); PG8_LDB(B1, 0, 1); PG8_SCHED; PG8_LDA(At, 0, 0); if (!rl) PG8_STAGE_A(PG8_SA(1, 1), a1 + hstep, 1, false, kb1);
            PG8_WAIT_VR(rl); PG8_WAIT_L(0); PG8_BAR; PG8_MMA(0, 0, At, B0); PG8_MMA(0, 1, At, B1); PG8_BAR; PG8_SCHED;
            PG8_LDA(At, 0, 1); PG8_STAGE(PG8_SB(0, 0), b2, voffB); PG8_STAGE(PG8_SB(0, 1), b2 + hstep, voffB); PG8_STAGE_A(PG8_SA(0, 0), a2, 0, last, kb2);
            PG8_WAIT_VR(rl); PG8_WAIT_L(0); PG8_BAR; PG8_MMA(1, 0, At, B0); PG8_MMA(1, 1, At, B1); PG8_BAR; PG8_SCHED;
            PG8_LDB(B0, 1, 0); PG8_LDB(B1, 1, 1); PG8_SCHED; PG8_LDA(At, 1, 0); PG8_STAGE_A(PG8_SA(0, 1), a2 + hstep, 1, last, kb2);
            PG8_WAIT_VR(rl); PG8_WAIT_L(0); PG8_BAR; PG8_MMA(0, 0, At, B0); PG8_MMA(0, 1, At, B1); PG8_BAR; PG8_SCHED;
            PG8_LDA(At, 1, 1); PG8_STAGE(PG8_SB(1, 0), b3, voffB); PG8_STAGE(PG8_SB(1, 1), b3 + hstep, voffB); PG8_STAGE_A(PG8_SA(1, 0), a3, 0, last, kb3);
            PG8_WAIT_V(8); PG8_WAIT_L(0); PG8_BAR; PG8_MMA(1, 0, At, B0); PG8_MMA(1, 1, At, B1); PG8_BAR; PG8_SCHED;
            } else {
            PG8_LDB(B0, 0, 0); PG8_SCHED; PG8_LDA(At, 0, 0); PG8_STAGE(PG8_SA(1, 1), a1 + hstep, voffA);
            PG8_WAIT_L(8); PG8_BAR; PG8_WAIT_L(0); PG8_MMA(0, 0, At, B0); PG8_BAR; PG8_SCHED;
            PG8_LDB(B1, 0, 1); PG8_STAGE(PG8_SB(0, 0), b2, voffB);
            PG8_BAR; PG8_WAIT_L(0); PG8_MMA(0, 1, At, B1); PG8_BAR;
            PG8_LDA(At, 0, 1); PG8_STAGE(PG8_SA(0, 0), a2, voffA);
            PG8_BAR; PG8_WAIT_L(0); PG8_MMA(1, 0, At, B0); PG8_BAR; PG8_SCHED;
            PG8_STAGE(PG8_SB(0, 1), b2 + hstep, voffB);
            PG8_WAIT_V(6); PG8_BAR; PG8_MMA(1, 1, At, B1); PG8_BAR;
            PG8_LDB(B0, 1, 0); PG8_SCHED; PG8_LDA(At, 1, 0); PG8_STAGE(PG8_SA(0, 1), a2 + hstep, voffA);
            PG8_WAIT_L(8); PG8_BAR; PG8_WAIT_L(0); PG8_MMA(0, 0, At, B0); PG8_BAR; PG8_SCHED;
            PG8_LDB(B1, 1, 1); PG8_STAGE(PG8_SB(1, 0), b3, voffB);
            PG8_BAR; PG8_WAIT_L(0); PG8_MMA(0, 1, At, B1); PG8_BAR;
            PG8_LDA(At, 1, 1); PG8_STAGE(PG8_SA(1, 0), a3, voffA);
            PG8_BAR; PG8_WAIT_L(0); PG8_MMA(1, 0, At, B0); PG8_BAR; PG8_SCHED;
            PG8_STAGE(PG8_SB(1, 1), b3 + hstep, voffB);
            PG8_WAIT_V(6); PG8_BAR; PG8_MMA(1, 1, At, B1); PG8_BAR;
            }
        }
        if constexpr (ALIGN_EPI) { if (wr == 0) PG8_BAR; }
        if constexpr (ALIGN_EPI && SP2) {
            relax = has_next && (Epi::ALWAYS_FULL || E.full(cur));
            if (relax) PG8_STAGE_A(PG8_SA(1, 1), nA + kstep + hstep, 1, true, kstep);
            asm volatile("" ::: "memory");
        }
        if constexpr (FP8SA != 0) asm volatile("s_nop 15\n\ts_nop 15" ::: "memory");
        if constexpr (!Epi::AFTER_DRAIN) { E(acc, cur, wr, wc, fr, fq); S.done(cur); }
        if (!has_next) break;
#pragma unroll
        for (int a = 0; a < 2; ++a)
#pragma unroll
            for (int b = 0; b < 2; ++b)
#pragma unroll
                for (int m = 0; m < 4; ++m)
#pragma unroll
                    for (int n = 0; n < 2; ++n) acc[a][b][m][n] = (f32x4){0.f, 0.f, 0.f, 0.f};
        cur = nxt; cA = nA; cB = nB; ++ui;
        if constexpr (Sched::GATHER) { _Pragma("unroll") for (int _h = 0; _h < 2; ++_h) _Pragma("unroll") for (int _i = 0; _i < 2; ++_i) ga[_h][_i] = gn[_h][_i]; }
        if constexpr (ALIGN_EPI) { if (wr == 1) PG8_BAR; }
    }
    PG8_WAIT_V(0);
    if constexpr (!ALIGN_EPI) { if (wr == 0) PG8_BAR; }
    PG8_BAR;
    if constexpr (Epi::AFTER_DRAIN) { E.fused(acc, cur, wr, wc, fr, fq, lds, wid, lane); S.done(cur); }
#undef PG8_SA
#undef PG8_SB
#undef PG8_STAGE
#undef PG8_STAGE_A
#undef PG8_GOFF
#undef PG8_LDA
#undef PG8_LDB
#undef PG8_MMA
#undef PG8_LD8
#undef PG8_WAIT_V
#undef PG8_WAIT_L
#undef PG8_BAR
#undef PG8_SCHED
}
}
#ifndef MK_N_LAUNCHES
#define MK_N_LAUNCHES 1
#endif
constexpr int NPHASES = 20;

constexpr int NTOK = 32768, DM = 1024, SEQ = 2048, NBATCH = 16, NLAYER = 2;
constexpr int PIN = 2832, PNP = 3072;
constexpr int PC_U = 0, PC_VV = 256, PC_Q = 512, PC_K = 768, PC_V = 1024, PC_OG = 1536, PC_CB = 2048, PC_CC = 2304, PC_CX = 2560, PC_G = 2816;
constexpr int NEXP = 32, DFF = 512;
constexpr int MAXSLOT = 73728;
constexpr int DUMMY_ROW = 65536;
constexpr float EPS = 1e-6f;

constexpr size_t MiB = 1u << 20;
constexpr size_t WS_CTL = 0, CTL_ZERO_BYTES = 131072;
constexpr size_t WS_WIN = 2 * MiB;
constexpr size_t WS_WOUT = 14 * MiB;
constexpr size_t WS_W13 = 18 * MiB;
constexpr size_t WS_W2 = 146 * MiB;
constexpr size_t WS_GW = 210 * MiB;
constexpr size_t WS_WR = 210 * MiB + 524288;
constexpr size_t WS_WG = 210 * MiB + 655360;
constexpr size_t WS_ROUTE = 211 * MiB;
constexpr size_t WS_X = 214 * MiB;
constexpr size_t WS_HY = 278 * MiB;
constexpr size_t WS_P = 342 * MiB;
constexpr size_t WS_H2 = 278 * MiB;
constexpr size_t WS_HID = 422 * MiB;
constexpr size_t WS_YE = 278 * MiB;
constexpr size_t WS_LIST = 534 * MiB;
constexpr size_t WS_END = 538 * MiB;
static_assert(WS_HID + (size_t)MAXSLOT * 512 * 2 <= WS_LIST && WS_YE + (size_t)65537 * 2048 <= WS_HID, "ws map");
constexpr size_t RT_E = 0;
constexpr size_t RT_POS = 131072;
constexpr size_t RT_W = 393216;
constexpr size_t RT_RSTD = 655360;
constexpr size_t RT_DST = 786432;
constexpr size_t RT_DEC = 1081344;
static_assert(RT_DEC + 2048 * 64 * 4 <= 3 * MiB, "route region");
constexpr int CW_BAR = 4096;
constexpr int CW_CNT = 16384;
constexpr size_t CTL_MOD = 131072;
static_assert(CTL_MOD >= CTL_ZERO_BYTES && CTL_MOD + 2 * 16 * 6144 * 4 <= 2 * MiB && (CW_CNT + 4 * 64 + 32) * 4 <= (int)CTL_ZERO_BYTES, "ctl");

constexpr int RING_BYTES = 131072;
constexpr int LTAB_OFF = 133120;
constexpr int LDSCTL_OFF = 162816;
constexpr int LDS_BYTES = 163840;
constexpr int NWAVES = 8;

#define GAS __attribute__((address_space(1)))
#define LAS __attribute__((address_space(3)))
typedef unsigned short bf16;
typedef unsigned v4u __attribute__((ext_vector_type(4)));
typedef unsigned v2u __attribute__((ext_vector_type(2)));
typedef float f32x4 __attribute__((ext_vector_type(4)));
typedef short bf16x8 __attribute__((ext_vector_type(8)));
typedef GAS unsigned gu32;
#define RLX_AGENT __ATOMIC_RELAXED, __HIP_MEMORY_SCOPE_AGENT
#define LDS_WAIT() asm volatile("s_waitcnt lgkmcnt(0)" ::: "memory")
__device__ __forceinline__ unsigned f2bf(float f) { unsigned u = __builtin_bit_cast(unsigned, f); return (u + 0x7fffu + ((u >> 16) & 1u)) >> 16; }
__device__ __forceinline__ unsigned pk2(float lo, float hi) { unsigned r; asm("v_cvt_pk_bf16_f32 %0, %1, %2" : "=v"(r) : "v"(lo), "v"(hi)); return r; }
#ifndef FP8_MASK
#define FP8_MASK 0xFE
#endif
#define FP8_ON(l, g) (((FP8_MASK) >> (4 * (l) + (g))) & 1)
#ifndef I8_MASK
#define I8_MASK 0x3
#endif
#define I8_ON(l) (((I8_MASK) >> (l)) & 1)
constexpr float WI8S = 127.0f * 32.0f / 5.5f;
#ifndef YE_FP8
#define YE_FP8 0
#endif
constexpr float W8S = 32.0f, H8S = 32.0f, Y8S = 4.0f, E8S = 8.0f;
constexpr int E8_ONE = 127, E8_W = 122, E8_H = 122, E8_Y = 125;
__device__ __forceinline__ unsigned pk4f8(float a, float b, float c, float d) {
    a = __builtin_amdgcn_fmed3f(a, -448.f, 448.f); b = __builtin_amdgcn_fmed3f(b, -448.f, 448.f); c = __builtin_amdgcn_fmed3f(c, -448.f, 448.f); d = __builtin_amdgcn_fmed3f(d, -448.f, 448.f);
    unsigned w = 0u; w = (unsigned)__builtin_amdgcn_cvt_pk_fp8_f32(a, b, (int)w, false); w = (unsigned)__builtin_amdgcn_cvt_pk_fp8_f32(c, d, (int)w, true); return w;
}
__device__ __forceinline__ unsigned pk4i8(float a, float b, float c, float d) {
    const int i0 = (int)__builtin_rintf(__builtin_amdgcn_fmed3f(a, -127.f, 127.f)), i1 = (int)__builtin_rintf(__builtin_amdgcn_fmed3f(b, -127.f, 127.f)),
              i2 = (int)__builtin_rintf(__builtin_amdgcn_fmed3f(c, -127.f, 127.f)), i3 = (int)__builtin_rintf(__builtin_amdgcn_fmed3f(d, -127.f, 127.f));
    return (unsigned)(i0 & 255) | ((unsigned)(i1 & 255) << 8) | ((unsigned)(i2 & 255) << 16) | ((unsigned)i3 << 24);
}
__device__ __forceinline__ float fexp(float x) { return __builtin_amdgcn_exp2f(x * 1.44269504f); }
__device__ __forceinline__ float flog(float x) { return __builtin_amdgcn_logf(x) * 0.69314718f; }
__device__ __forceinline__ float bf2f(unsigned short h) { return __uint_as_float((unsigned)h << 16); }
__device__ __forceinline__ float bflo(unsigned w) { return __uint_as_float(w << 16); }
__device__ __forceinline__ float bfhi(unsigned w) { return __uint_as_float(w & 0xffff0000u); }
#define DPP_F(x, ctrl) __int_as_float(__builtin_amdgcn_update_dpp(0, __float_as_int(x), (ctrl), 0xf, 0xf, true))
__device__ __forceinline__ float row_sum16(float v) {
    v += DPP_F(v, 0xB1); v += DPP_F(v, 0x4E); v += DPP_F(v, 0x141); v += DPP_F(v, 0x140);
    return v;
}
__device__ __forceinline__ float row_prefix16(float v) {
    v += DPP_F(v, 0x111); v += DPP_F(v, 0x112); v += DPP_F(v, 0x114); v += DPP_F(v, 0x118);
    return v;
}
__device__ __forceinline__ float wave_max_nonneg(float v) {
    v = fmaxf(v, DPP_F(v, 0xB1)); v = fmaxf(v, DPP_F(v, 0x4E)); v = fmaxf(v, DPP_F(v, 0x141)); v = fmaxf(v, DPP_F(v, 0x140));
    const int i = __float_as_int(v);
    return fmaxf(fmaxf(__int_as_float(__builtin_amdgcn_readlane(i, 0)), __int_as_float(__builtin_amdgcn_readlane(i, 16))), fmaxf(__int_as_float(__builtin_amdgcn_readlane(i, 32)), __int_as_float(__builtin_amdgcn_readlane(i, 48))));
}
__device__ __forceinline__ float wave_sum(float v) {
    v = row_sum16(v);
    const int i = __float_as_int(v);
    return (__int_as_float(__builtin_amdgcn_readlane(i, 0)) + __int_as_float(__builtin_amdgcn_readlane(i, 16))) + (__int_as_float(__builtin_amdgcn_readlane(i, 32)) + __int_as_float(__builtin_amdgcn_readlane(i, 48)));
}

#define XB_TMO      128
#define XB_XCNT(j)  (256  + 64 * (j))
#define XB_XSUB(j)  (1280 + 64 * (j))
#define XB_XGEN(j)  (2304 + 64 * (j))
#define XB_TOP      3328
#define XB_TOPGEN   3392
#define XB_GRP(r)   (3520 + 64 * (r))
#define XCD_BAR_WORDS 4096
#define XB_SPIN_CAP (1u << 21)
__device__ __forceinline__ unsigned xb_ld(unsigned* p)              { return __hip_atomic_load(p, __ATOMIC_RELAXED, __HIP_MEMORY_SCOPE_AGENT); }
__device__ __forceinline__ unsigned xb_add(unsigned* p, unsigned v) { return __hip_atomic_fetch_add(p, v, __ATOMIC_RELAXED, __HIP_MEMORY_SCOPE_AGENT); }
__device__ __forceinline__ unsigned xb_xcc_id() { return (unsigned)__builtin_amdgcn_s_getreg((3 << 11) | 20) & 0xFu; }
#define XB_SPIN(cond, bar) do { unsigned _sp = 0; while (cond) { __builtin_amdgcn_s_sleep(1); \
    if ((++_sp & 255u) == 0u) { if (xb_ld(&(bar)[XB_TMO])) break; if (_sp > XB_SPIN_CAP) { atomicAdd(&(bar)[XB_TMO], 1u); break; } } } } while (0)
struct XcdBarrier { unsigned* bar; unsigned x; volatile LAS unsigned* st; };
__device__ __forceinline__ XcdBarrier xcd_barrier_post(unsigned* bar, volatile LAS unsigned* st) {
    XcdBarrier b; b.bar = bar; b.x = xb_xcc_id(); b.st = st;
    if (threadIdx.x == 0) { (void)__hip_atomic_fetch_or(&bar[XB_GRP(blockIdx.x & 7u)], 1u << b.x, __ATOMIC_RELAXED, __HIP_MEMORY_SCOPE_AGENT); (void)xb_add(&bar[XB_XCNT(b.x)], 1u); }
    return b;
}
__device__ __forceinline__ void xcd_barrier_complete(unsigned* bar, unsigned x, unsigned& nloc, unsigned& nx) {
    const unsigned G = gridDim.x * gridDim.y * gridDim.z;
    unsigned sum, cnt, mine, sp = 0u;
    for (;;) {
        sum = 0u; cnt = 0u; mine = 0u;
#pragma unroll
        for (unsigned j = 0; j < 16; ++j) { const unsigned c = xb_ld(&bar[XB_XCNT(j)]); sum += c; cnt += (c > 0u) ? 1u : 0u; mine = (j == x) ? c : mine; }
        if (sum == G) break;
        __builtin_amdgcn_s_sleep(1);
        if ((++sp & 255u) == 0u) { if (xb_ld(&bar[XB_TMO])) break; if (sp > XB_SPIN_CAP) { atomicAdd(&bar[XB_TMO], 1u); break; } }
    }
    nloc = mine > 0u ? mine : 1u; nx = cnt > 0u ? cnt : 1u;
}
__device__ __forceinline__ void xcd_barrier(const XcdBarrier& b, bool leader, bool local = false) {
    asm volatile("s_waitcnt vmcnt(0)" ::: "memory");
    __syncthreads();
    if (leader) {
        unsigned* bar = b.bar;
        __builtin_amdgcn_s_waitcnt(0);
        unsigned nloc = b.st[0], nx = b.st[1]; const unsigned placed = b.st[2];
        if (nloc == 0u) { xcd_barrier_complete(bar, b.x, nloc, nx); b.st[0] = nloc; b.st[1] = nx; }
        const bool loc = local && placed == 1u;
        const unsigned old = xb_add(&bar[XB_XSUB(b.x)], 1u);
        const unsigned gen = old / nloc;
        if (old + 1u == (gen + 1u) * nloc) {
            if (!loc) {
                __builtin_amdgcn_fence(__ATOMIC_RELEASE, "agent");
                asm volatile("s_waitcnt vmcnt(0)" ::: "memory");
                const unsigned og = xb_add(&bar[XB_TOP], 1u);
                const unsigned tg = og / nx;
                if (og + 1u == (tg + 1u) * nx) xb_add(&bar[XB_TOPGEN], 1u);
                else XB_SPIN(xb_ld(&bar[XB_TOPGEN]) == tg, bar);
            }
            __builtin_amdgcn_fence(__ATOMIC_ACQUIRE, "agent");
            xb_add(&bar[XB_XGEN(b.x)], 1u);
            asm volatile("s_waitcnt vmcnt(0)" ::: "memory");
        } else if (loc) {
            __builtin_amdgcn_fence(__ATOMIC_ACQUIRE, "agent");
            XB_SPIN(xb_ld(&bar[XB_XGEN(b.x)]) == gen, bar);
            asm volatile("s_waitcnt vmcnt(0)" ::: "memory");
        } else {
            XB_SPIN(xb_ld(&bar[XB_XGEN(b.x)]) == gen, bar);
            __builtin_amdgcn_fence(__ATOMIC_ACQUIRE, "agent");
            asm volatile("s_waitcnt vmcnt(0)" ::: "memory");
        }
        if (placed == 0u) {
            unsigned all = 0u; bool ok = true;
#pragma unroll
            for (unsigned r = 0; r < 8; ++r) { const unsigned m = xb_ld(&bar[XB_GRP(r)]); ok = ok && m != 0u && (m & (m - 1u)) == 0u && (all & m) == 0u; all |= m; }
            b.st[2] = ok ? 1u : 2u;
        }
    }
    __syncthreads();
}

typedef const float* fptr_t;
typedef const __attribute__((address_space(4))) fptr_t* KArgPtr;
struct Frame {
    LAS unsigned char* lds;
    int tid, lane, wave, vcu, G;
    KArgPtr inp;
    float* out; unsigned char* ws;
};
enum { I_X = 0, I_C, I_WADA, I_BADA, I_GN1, I_GN2, I_WIN, I_WOUT, I_LNG, I_LNB, I_GWS, I_GBS, I_WGATE, I_BGATE, I_GLAG, I_CONVW, I_CONVB, I_RW, I_RB, I_W1, I_W3, I_W2, I_GF };
__device__ __forceinline__ bf16* wsb(const Frame& F, size_t off) { return (bf16*)(F.ws + off); }
__device__ __forceinline__ float* hsp(const Frame& F) { return (float*)(F.ws + WS_ROUTE + RT_RSTD); }
__device__ __forceinline__ bf16* h8p(const Frame& F) { return (bf16*)((unsigned char*)F.out + 96 * MiB); }
__device__ __forceinline__ const float* modp(const Frame& F, int l) { return (const float*)(F.ws + WS_CTL + CTL_MOD) + (size_t)l * 16 * 6144; }

struct TrItem { const float* W; bf16* WT; int ldw, n0, nv, k0, ldk, d0, fp8; };
constexpr int TR_IN = 16 * 45, TR_OUT = 16 * 16, TR_E = 2 * 128 + 128, TR_L = TR_IN + TR_OUT + 32 * TR_E;
__device__ __forceinline__ TrItem tr_decode(const Frame& F, int it) {
    TrItem t; const int l = it / TR_L; int r = it % TR_L; t.nv = 64; t.fp8 = 0;
    if (r < TR_IN) { const int kb = r / 45, nb = r % 45;
        if (nb < 24) { t.n0 = 64 * nb; t.d0 = t.n0; } else if (nb < 44) { t.n0 = 1552 + 64 * (nb - 24); t.d0 = 1536 + 64 * (nb - 24); } else { t.n0 = 1536; t.d0 = 2816; t.nv = 16; }
        t.W = F.inp[I_WIN] + (size_t)l * DM * PIN; t.ldw = PIN; t.k0 = 64 * kb; t.WT = wsb(F, WS_WIN) + (size_t)l * PNP * DM; t.ldk = DM; t.fp8 = I8_ON(l) ? 2 : FP8_ON(l, 0); return t; }
    r -= TR_IN;
    if (r < TR_OUT) { const int kb = r / 16, nb = r % 16;
        t.W = F.inp[I_WOUT] + (size_t)l * DM * DM; t.ldw = DM; t.n0 = 64 * nb; t.k0 = 64 * kb; t.WT = wsb(F, WS_WOUT) + (size_t)l * DM * DM; t.ldk = DM; t.d0 = 64 * nb; t.fp8 = FP8_ON(l, 1); return t; }
    r -= TR_OUT;
    const int e = r / TR_E; r %= TR_E; const size_t le = (size_t)l * NEXP + e;
    if (r < 256) { const int s = r >> 7, rr = r & 127, kb = rr / 8, nb = rr % 8;
        t.W = F.inp[s ? I_W3 : I_W1] + le * DM * DFF; t.ldw = DFF; t.n0 = 64 * nb; t.k0 = 64 * kb; t.WT = wsb(F, WS_W13) + le * DM * DM; t.ldk = DM; t.d0 = 256 * (t.n0 >> 7) + 128 * s + (t.n0 & 127); t.fp8 = FP8_ON(l, 2); return t; }
    r -= 256;
    { const int kb = r / 16, nb = r % 16; t.fp8 = FP8_ON(l, 3);
        t.W = F.inp[I_W2] + le * DFF * DM; t.ldw = DM; t.n0 = 64 * nb; t.k0 = 64 * kb; t.WT = wsb(F, WS_W2) + le * DM * DFF; t.ldk = DFF; t.d0 = 64 * nb; return t; }
}
__device__ __forceinline__ void tr_load(const TrItem& t, float (&r)[64], int lane) {
    const int kq = lane >> 4, nq = (lane & 15) * 4;
    const float* p = t.W + (size_t)(t.k0 + kq) * t.ldw + t.n0 + nq; const bool ok = nq < t.nv;
#pragma unroll
    for (int i = 0; i < 16; ++i) { const f32x4 v = ok ? __builtin_nontemporal_load((const f32x4*)(p + (size_t)(4 * i) * t.ldw)) : (f32x4){0.f, 0.f, 0.f, 0.f};
        r[4 * i] = v[0]; r[4 * i + 1] = v[1]; r[4 * i + 2] = v[2]; r[4 * i + 3] = v[3]; }
}
__device__ __forceinline__ void tr_store(const TrItem& t, const float (&r)[64], LAS float* scr, int lane, int var) {
    { const int kq = lane >> 4, nq = (lane & 15) * 4;
#pragma unroll
      for (int i = 0; i < 64; ++i) scr[(4 * (i >> 2) + kq) * 65 + nq + (i & 3)] = r[i]; }
    LDS_WAIT(); asm volatile("" ::: "memory");
    const int ck = lane & 7;
#pragma unroll
    for (int j = 0; j < 8; ++j) { const int n = (lane >> 3) + 8 * j; const LAS float* s = scr + (8 * ck) * 65 + n;
        if (var == 1) continue;
        if (t.fp8 == 2) { if (n < t.nv) *(v2u*)((unsigned char*)t.WT + (size_t)(t.d0 + n) * t.ldk + t.k0 + 8 * ck) = (v2u){pk4i8(s[0 * 65] * WI8S, s[1 * 65] * WI8S, s[2 * 65] * WI8S, s[3 * 65] * WI8S), pk4i8(s[4 * 65] * WI8S, s[5 * 65] * WI8S, s[6 * 65] * WI8S, s[7 * 65] * WI8S)}; }
        else if (t.fp8) { if (n < t.nv) *(v2u*)((unsigned char*)t.WT + (size_t)(t.d0 + n) * t.ldk + t.k0 + 8 * ck) = (v2u){pk4f8(s[0 * 65] * W8S, s[1 * 65] * W8S, s[2 * 65] * W8S, s[3 * 65] * W8S), pk4f8(s[4 * 65] * W8S, s[5 * 65] * W8S, s[6 * 65] * W8S, s[7 * 65] * W8S)}; }
        else { v4u o; o.x = pk2(s[0 * 65], s[1 * 65]); o.y = pk2(s[2 * 65], s[3 * 65]); o.z = pk2(s[4 * 65], s[5 * 65]); o.w = pk2(s[6 * 65], s[7 * 65]);
            if (n < t.nv) *(v4u*)(t.WT + (size_t)(t.d0 + n) * t.ldk + t.k0 + 8 * ck) = o; } }
    LDS_WAIT(); asm volatile("" ::: "memory");
}
__device__ __forceinline__ void p0_prologue(Frame& F, int var) {
    LAS float* scr = (LAS float*)(F.lds + F.wave * 16640);
    const int gw = F.vcu * NWAVES + F.wave, NGW = F.G * NWAVES;
    constexpr int NITEMS = 2 * TR_L;
    for (int it = gw; it < NITEMS; it += NGW) {
        const TrItem ta = tr_decode(F, NITEMS - 1 - it);
        float ra[64];
        tr_load(ta, ra, F.lane);
        if (var == 2) { float sacc = 0.f; _Pragma("unroll") for (int i = 0; i < 64; ++i) sacc += ra[i]; if (sacc == 1.2345e30f) scr[F.lane] = sacc; }
        else tr_store(ta, ra, scr, F.lane, var);
    }
    { const int idx = F.vcu * 512 + F.tid;
      if (idx < 2 * 4 * 128 * 128) { const int s = idx & 127, t = (idx >> 7) & 127; const float w = F.inp[I_GWS][idx];
          wsb(F, WS_GW)[idx] = (bf16)f2bf(((t >> 6) >= (s >> 6)) ? w : 0.f); } }
    { const int idx = F.vcu * 512 + F.tid; if (idx < 32 * 1024) wsb(F, WS_WR)[idx] = (bf16)f2bf(F.inp[I_RW][(idx & 1023) * 32 + (idx >> 10)]); }
    { const int idx = F.vcu * 512 + F.tid; if (idx < 2 * 256 * 16) wsb(F, WS_WG)[idx] = (bf16)f2bf(F.inp[I_WGATE][((idx >> 12) * 16 + (idx & 15)) * 256 + ((idx >> 4) & 255)]); }
    __syncthreads();
    {
        const int l = F.vcu >> 7, cbase = (F.vcu & 127) * 48, kg = F.tid >> 4, cl = F.tid & 15;
        LAS float* sc = (LAS float*)F.lds;
        { float cv[32];
#pragma unroll
          for (int i = 0; i < 32; ++i) cv[i] = F.inp[I_C][F.tid + 512 * i];
#pragma unroll
          for (int i = 0; i < 32; ++i) sc[F.tid + 512 * i] = cv[i] / (1.0f + __expf(-cv[i])); }
        __syncthreads();
        float acc[3][16];
#pragma unroll
        for (int q = 0; q < 3; ++q)
#pragma unroll
            for (int b = 0; b < 16; ++b) acc[q][b] = 0.f;
        const float* wp = F.inp[I_WADA] + (size_t)l * DM * 6144 + cbase + cl;
#pragma unroll 1
        for (int g8 = 0; g8 < 4; ++g8) { float wv[8][3];
#pragma unroll
            for (int i = 0; i < 8; ++i) { const size_t ko = (size_t)(kg + 32 * (8 * g8 + i)) * 6144; wv[i][0] = wp[ko]; wv[i][1] = wp[ko + 16]; wv[i][2] = wp[ko + 32]; }
#pragma unroll
            for (int i = 0; i < 8; ++i) { const int k = kg + 32 * (8 * g8 + i); const float w0 = wv[i][0], w1 = wv[i][1], w2 = wv[i][2];
#pragma unroll
                for (int b = 0; b < 16; ++b) { const float s = sc[b * 1024 + k]; acc[0][b] += s * w0; acc[1][b] += s * w1; acc[2][b] += s * w2; } } }
        __syncthreads();
        LAS float* part = (LAS float*)F.lds;
#pragma unroll
        for (int q = 0; q < 3; ++q)
#pragma unroll
            for (int b = 0; b < 16; ++b) part[(kg * 48 + cl + 16 * q) * 16 + b] = acc[q][b];
        __syncthreads();
        for (int t = F.tid; t < 768; t += 512) { const int col = t >> 4, b = t & 15; float sum = F.inp[I_BADA][l * 6144 + cbase + col];
            for (int g = 0; g < 32; ++g) sum += part[(g * 48 + col) * 16 + b];
            ((float*)(F.ws + WS_CTL + CTL_MOD))[((size_t)l * 16 + b) * 6144 + cbase + col] = sum; }
    }
}

__device__ __forceinline__ void write_normed(const f32x4 (&v)[4], float rstd, const float* g, const float* sc, const float* sh, bf16* orow, int lane) {
#pragma unroll
    for (int j = 0; j < 4; ++j) { const int c = 4 * lane + 256 * j;
        const f32x4 g4 = *(const f32x4*)(g + c), s4 = *(const f32x4*)(sc + c), h4 = *(const f32x4*)(sh + c);
        const f32x4 o = v[j] * rstd * g4 * (s4 + 1.0f) + h4;
        v2u w; w.x = pk2(o[0], o[1]); w.y = pk2(o[2], o[3]); *(v2u*)(orow + c) = w; }
}
__device__ __forceinline__ float row_rstd(const f32x4 (&v)[4]) {
    float s = 0.f;
#pragma unroll
    for (int j = 0; j < 4; ++j) s += (v[j][0] * v[j][0] + v[j][1] * v[j][1]) + (v[j][2] * v[j][2] + v[j][3] * v[j][3]);
    return 1.0f / sqrtf(wave_sum(s) * (1.0f / DM) + EPS);
}
__device__ __forceinline__ void norm_vectors(const float* g, const float* sc, const float* sh, int lane, f32x4 (&gs)[4], f32x4 (&shv)[4]) {
#pragma unroll
    for (int j = 0; j < 4; ++j) { const int c = 4 * lane + 256 * j; gs[j] = *(const f32x4*)(g + c) * (*(const f32x4*)(sc + c) + 1.0f); shv[j] = *(const f32x4*)(sh + c); }
}
__device__ __forceinline__ void store_normed(const f32x4 (&v)[4], float rstd, const f32x4 (&gs)[4], const f32x4 (&shv)[4], bf16* H, size_t row, int lane, int mode, float* hs) {
    f32x4 o[4];
#pragma unroll
    for (int j = 0; j < 4; ++j) o[j] = v[j] * rstd * gs[j] + shv[j];
    if (mode == 2) { float m = 0.f;
#pragma unroll
        for (int j = 0; j < 4; ++j) m = fmaxf(fmaxf(m, fmaxf(fabsf(o[j][0]), fabsf(o[j][1]))), fmaxf(fabsf(o[j][2]), fabsf(o[j][3])));
        m = fmaxf(wave_max_nonneg(m), 1e-20f); const float s = 127.0f / m;
#pragma unroll
        for (int j = 0; j < 4; ++j) *(unsigned*)((unsigned char*)H + row * DM + 4 * lane + 256 * j) = pk4i8(o[j][0] * s, o[j][1] * s, o[j][2] * s, o[j][3] * s);
        if (lane == 0) hs[row] = m * (1.0f / 127.0f); }
    else {
#pragma unroll
        for (int j = 0; j < 4; ++j) { if (mode == 1) *(unsigned*)((unsigned char*)H + row * DM + 4 * lane + 256 * j) = pk4f8(o[j][0], o[j][1], o[j][2], o[j][3]);
            else *(v2u*)(H + row * DM + 4 * lane + 256 * j) = (v2u){pk2(o[j][0], o[j][1]), pk2(o[j][2], o[j][3])}; } }
}
#define HMODE(l) (I8_ON(l) ? 2 : (FP8_ON(l, 0) ? 1 : 0))
__device__ __forceinline__ void p1_first_norm(Frame& F) {
    const int gw = F.vcu * NWAVES + F.wave, row0 = gw * 16, b = row0 >> 11;
    const float* mod = modp(F, 0) + b * 6144; bf16* X = wsb(F, WS_X); bf16* H = wsb(F, WS_HY);
    f32x4 gs[4], shv[4]; norm_vectors(F.inp[I_GN1], mod + 1024, mod, F.lane, gs, shv);
    for (int i = 0; i < 16; i += 2) {
        f32x4 va[4], vb[4];
#pragma unroll
        for (int j = 0; j < 4; ++j) { va[j] = __builtin_nontemporal_load((const f32x4*)(F.inp[I_X] + (size_t)(row0 + i) * DM + 4 * F.lane + 256 * j)); vb[j] = __builtin_nontemporal_load((const f32x4*)(F.inp[I_X] + (size_t)(row0 + i + 1) * DM + 4 * F.lane + 256 * j)); }
        const float ra = row_rstd(va), rb = row_rstd(vb);
#pragma unroll
        for (int j = 0; j < 4; ++j) { *(v2u*)(X + (size_t)(row0 + i) * DM + 4 * F.lane + 256 * j) = (v2u){pk2(va[j][0], va[j][1]), pk2(va[j][2], va[j][3])};
                                      *(v2u*)(X + (size_t)(row0 + i + 1) * DM + 4 * F.lane + 256 * j) = (v2u){pk2(vb[j][0], vb[j][1]), pk2(vb[j][2], vb[j][3])}; }
        store_normed(va, ra, gs, shv, HMODE(0) ? h8p(F) : H, (size_t)(row0 + i), F.lane, HMODE(0), hsp(F)); store_normed(vb, rb, gs, shv, HMODE(0) ? h8p(F) : H, (size_t)(row0 + i + 1), F.lane, HMODE(0), hsp(F));
    }
}
__device__ __forceinline__ void combine_row(const bf16* X, const bf16* YE, const float* rw, const f32x4 (&gt)[4], int row, int lane, f32x4 (&v)[4]) {
    const float w0 = rw[2 * row], w1 = rw[2 * row + 1];
#pragma unroll
    for (int j = 0; j < 4; ++j) { const int c = 4 * lane + 256 * j;
        const v2u xv = __builtin_nontemporal_load((const v2u*)(X + (size_t)row * DM + c));
        if (YE_FP8) { typedef float f32x2 __attribute__((ext_vector_type(2)));
            const unsigned q0 = *(const unsigned*)((const unsigned char*)YE + (size_t)row * DM + c), q1 = *(const unsigned*)((const unsigned char*)YE + (size_t)(NTOK + row) * DM + c);
            const f32x2 a0 = __builtin_amdgcn_cvt_pk_f32_fp8(q0, false), a1 = __builtin_amdgcn_cvt_pk_f32_fp8(q0, true), b0 = __builtin_amdgcn_cvt_pk_f32_fp8(q1, false), b1 = __builtin_amdgcn_cvt_pk_f32_fp8(q1, true);
            const float u0 = w0 * (1.0f / E8S), u1 = w1 * (1.0f / E8S);
            v[j][0] = bflo(xv.x) + gt[j][0] * (u0 * a0.x + u1 * b0.x); v[j][1] = bfhi(xv.x) + gt[j][1] * (u0 * a0.y + u1 * b0.y);
            v[j][2] = bflo(xv.y) + gt[j][2] * (u0 * a1.x + u1 * b1.x); v[j][3] = bfhi(xv.y) + gt[j][3] * (u0 * a1.y + u1 * b1.y); }
        else { const v2u y0 = __builtin_nontemporal_load((const v2u*)(YE + (size_t)row * DM + c)), y1 = __builtin_nontemporal_load((const v2u*)(YE + (size_t)(NTOK + row) * DM + c));
            v[j][0] = bflo(xv.x) + gt[j][0] * (w0 * bflo(y0.x) + w1 * bflo(y1.x)); v[j][1] = bfhi(xv.x) + gt[j][1] * (w0 * bfhi(y0.x) + w1 * bfhi(y1.x));
            v[j][2] = bflo(xv.y) + gt[j][2] * (w0 * bflo(y0.y) + w1 * bflo(y1.y)); v[j][3] = bfhi(xv.y) + gt[j][3] * (w0 * bfhi(y0.y) + w1 * bfhi(y1.y)); } }
}
__device__ __forceinline__ void p9_combine(Frame& F, int l, bool dry  ) {
    const int gw = F.vcu * NWAVES + F.wave, row0 = gw * 16, b = row0 >> 11;
    const float* mod = modp(F, l) + b * 6144; const bf16* X = wsb(F, WS_X); bf16* Xo = dry ? (bf16*)F.out : wsb(F, WS_X); bf16* H = dry ? (bf16*)F.out + (size_t)NTOK * DM : wsb(F, WS_HY); const bf16* YE = wsb(F, WS_YE);
    const float* rw = (const float*)(F.ws + WS_ROUTE + RT_W);
    f32x4 gt[4], gs[4], shv[4];
#pragma unroll
    for (int j = 0; j < 4; ++j) gt[j] = *(const f32x4*)(mod + 5120 + 4 * F.lane + 256 * j);
    if (l == NLAYER - 1) {
#pragma unroll
        for (int j = 0; j < 4; ++j) gs[j] = *(const f32x4*)(F.inp[I_GF] + 4 * F.lane + 256 * j);
    } else { const float* mod1 = modp(F, l + 1) + b * 6144; norm_vectors(F.inp[I_GN1] + (l + 1) * DM, mod1 + 1024, mod1, F.lane, gs, shv); }
    for (int i = 0; i < 16; i += 2) {
        f32x4 va[4], vb[4]; combine_row(X, YE, rw, gt, row0 + i, F.lane, va); combine_row(X, YE, rw, gt, row0 + i + 1, F.lane, vb);
        const float ra = row_rstd(va), rb = row_rstd(vb);
        if (l == NLAYER - 1) {
#pragma unroll
            for (int j = 0; j < 4; ++j) { *(f32x4*)(F.out + (size_t)(row0 + i) * DM + 4 * F.lane + 256 * j) = va[j] * ra * gs[j]; *(f32x4*)(F.out + (size_t)(row0 + i + 1) * DM + 4 * F.lane + 256 * j) = vb[j] * rb * gs[j]; }
        } else {
#pragma unroll
            for (int j = 0; j < 4; ++j) { *(v2u*)(Xo + (size_t)(row0 + i) * DM + 4 * F.lane + 256 * j) = (v2u){pk2(va[j][0], va[j][1]), pk2(va[j][2], va[j][3])};
                                          *(v2u*)(Xo + (size_t)(row0 + i + 1) * DM + 4 * F.lane + 256 * j) = (v2u){pk2(vb[j][0], vb[j][1]), pk2(vb[j][2], vb[j][3])}; }
            store_normed(va, ra, gs, shv, HMODE(l + 1) ? h8p(F) : H, (size_t)(row0 + i), F.lane, HMODE(l + 1), hsp(F)); store_normed(vb, rb, gs, shv, HMODE(l + 1) ? h8p(F) : H, (size_t)(row0 + i + 1), F.lane, HMODE(l + 1), hsp(F));
        }
    }
}
constexpr int P64 = 144, P128 = 272;
typedef unsigned short u16x4 __attribute__((ext_vector_type(4)));
__device__ __forceinline__ bf16x8 ldfrag(const LAS unsigned char* tile, int pitch, int r0, int k0, int fr, int fq) { return *(const LAS bf16x8*)(tile + (r0 + fr) * pitch + (k0 + 8 * fq) * 2); }
__device__ __forceinline__ f32x4 mma16(bf16x8 a, bf16x8 b, f32x4 c) { return __builtin_amdgcn_mfma_f32_16x16x32_bf16(b, a, c, 0, 0, 0); }
__device__ __forceinline__ void lbar() { asm volatile("s_waitcnt lgkmcnt(0)" ::: "memory"); __builtin_amdgcn_s_barrier(); asm volatile("" ::: "memory"); }
__device__ __forceinline__ void trfrag2(unsigned a0, unsigned a1, unsigned b0, unsigned b1, bf16x8& fa, bf16x8& fb) {
    u16x4 r0, r1, r2, r3;
    asm volatile("ds_read_b64_tr_b16 %0, %4\n\tds_read_b64_tr_b16 %1, %5\n\tds_read_b64_tr_b16 %2, %6\n\tds_read_b64_tr_b16 %3, %7\n\ts_waitcnt lgkmcnt(0)"
                 : "=&v"(r0), "=&v"(r1), "=&v"(r2), "=&v"(r3) : "v"(a0), "v"(a1), "v"(b0), "v"(b1) : "memory");
    fa = __builtin_bit_cast(bf16x8, __builtin_shufflevector(r0, r1, 0, 1, 2, 3, 4, 5, 6, 7)); fb = __builtin_bit_cast(bf16x8, __builtin_shufflevector(r2, r3, 0, 1, 2, 3, 4, 5, 6, 7));
}
__device__ __forceinline__ unsigned offb(unsigned row, unsigned ch) { return 256u * row + 16u * (ch ^ (((row & 3) << 2) | ((row >> 2) & 3))); }
constexpr int MX_TB = 0  , MX_SSQ = 5120, MX_GG = 5632  , MX_QT = 8192, MX_KT = MX_QT + 64 * P64, MX_QH = MX_KT + 64 * P64, MX_SC = MX_QH + 64 * P64,
              MX_ST = MX_SC + 64 * P64, MX_VI = MX_ST + 128 * P64, MX_WG = MX_VI + 64 * 256  , MX_BGL = MX_WG + 8192  , MX_END = MX_BGL + 1024;
constexpr int MS_KI = 8192, MS_VI = MS_KI + 64 * P64, MS_SET = 64 * P64 + 64 * 80;
constexpr int MX_VN = 8192;
static_assert(MX_END <= RING_BYTES && MX_VN + 256 * P128 <= RING_BYTES && (MX_VI & 255) == 0, "mixer LDS");

__device__ __forceinline__ void gate_stage(Frame& F, int l) {
    *(LAS v4u*)(F.lds + MX_WG + F.tid * 16) = *(const v4u*)(wsb(F, WS_WG) + (size_t)l * 4096 + F.tid * 8);
    if (F.tid < 256) ((LAS float*)(F.lds + MX_BGL))[F.tid] = F.inp[I_BGATE][l * 256 + F.tid];
}
__device__ __forceinline__ v4u gate_load(Frame& F, int tok0) {
    const int fr = F.lane & 15, fq = F.lane >> 4, mt = F.wave >> 1;
    return *(const v4u*)(wsb(F, WS_P) + (size_t)(tok0 + 16 * mt + fr) * PNP + PC_G + 8 * (fq & 1));
}
__device__ __forceinline__ void gate_prefix(Frame& F, const v4u ga, int h, float (&pb)[2][4], LAS float* tb) {
    const int fr = F.lane & 15, fq = F.lane >> 4, mt = F.wave >> 1, nt0 = 2 * (F.wave & 1);
    const v4u zero4 = (v4u){0u, 0u, 0u, 0u};
    const bf16x8 a = __builtin_bit_cast(bf16x8, (fq < 2) ? ga : zero4);
#pragma unroll
    for (int q = 0; q < 2; ++q) { const int kt = h * 64 + 16 * (nt0 + q);
        const v4u wv = *(const LAS v4u*)(F.lds + MX_WG + ((kt + fr) * 16 + 8 * (fq & 1)) * 2);
        const bf16x8 bw = __builtin_bit_cast(bf16x8, (fq < 2) ? wv : zero4);
        const f32x4 z = mma16(a, bw, *(const LAS f32x4*)(F.lds + MX_BGL + (kt + 4 * fq) * 4));
#pragma unroll
        for (int r = 0; r < 4; ++r) { float x = (fminf(z[r], 0.f) - flog(1.0f + fexp(-fabsf(z[r])))) * (1.0f / 16.0f);
            pb[q][r] = row_prefix16(x); }
        const int k0 = 16 * (nt0 + q) + 4 * fq;
        if (fr == 15) *(LAS f32x4*)(tb + mt * 64 + k0) = (f32x4){pb[q][0], pb[q][1], pb[q][2], pb[q][3]};
        if (mt == 2 && fr == 0) *(LAS f32x4*)(tb + 256 + k0) = (f32x4){pb[q][0], pb[q][1], pb[q][2], pb[q][3]}; }
}
__device__ __forceinline__ void gate_finish(Frame& F, const LAS float* tb, float (&pb)[2][4], float (&bref)[2][4], float (&blast)[2][4]) {
    const int fq = F.lane >> 4, mt = F.wave >> 1, nt0 = 2 * (F.wave & 1);
#pragma unroll
    for (int q = 0; q < 2; ++q) { const int k0 = 16 * (nt0 + q) + 4 * fq;
        const f32x4 t0 = *(const LAS f32x4*)(tb + k0), t1 = *(const LAS f32x4*)(tb + 64 + k0), t2 = *(const LAS f32x4*)(tb + 128 + k0), t3 = *(const LAS f32x4*)(tb + 192 + k0), g32 = *(const LAS f32x4*)(tb + 256 + k0);
#pragma unroll
        for (int r = 0; r < 4; ++r) { const float off = ((mt > 0) ? t0[r] : 0.f) + ((mt > 1) ? t1[r] : 0.f) + ((mt > 2) ? t2[r] : 0.f);
            pb[q][r] += off; bref[q][r] = t0[r] + t1[r] + g32[r]; blast[q][r] = (t0[r] + t1[r]) + (t2[r] + t3[r]); } }
}

__device__ __forceinline__ bf16* gla_arr(const Frame& F, int which) { return (bf16*)F.out + (size_t)(16 + 8 * which) * 1024 * 1024; }
struct PrepIn { v4u ga; v2u q[2], k[2]; };
__device__ __forceinline__ void prep_load(Frame& F, int item, PrepIn& p) {
    const int fr = F.lane & 15, fq = F.lane >> 4, mt = F.wave >> 1, nt0 = 2 * (F.wave & 1), h = item & 3, tok0 = (item >> 2) * 64;
    p.ga = gate_load(F, tok0);
    const bf16* pr = wsb(F, WS_P) + (size_t)(tok0 + 16 * mt + fr) * PNP + h * 64 + 4 * fq;
#pragma unroll
    for (int q = 0; q < 2; ++q) { p.q[q] = *(const v2u*)(pr + PC_Q + 16 * (nt0 + q)); p.k[q] = *(const v2u*)(pr + PC_K + 16 * (nt0 + q)); }
}
__device__ __forceinline__ void p3p_gla_prep(Frame& F, int l) {
    const int fr = F.lane & 15, fq = F.lane >> 4, w = F.wave, mt = w >> 1, nt0 = 2 * (w & 1);
    PrepIn ring[3]; prep_load(F, F.vcu * 8, ring[0]); prep_load(F, F.vcu * 8 + 1, ring[1]); ring[2] = ring[0];
    bf16* QT = gla_arr(F, 0); bf16* KT = gla_arr(F, 1); bf16* QH = gla_arr(F, 2); bf16* KH = gla_arr(F, 3); float* dec = (float*)(F.ws + WS_ROUTE + RT_DEC);
    __syncthreads();
    gate_stage(F, l);
    __syncthreads();
    for (int i3 = 0; i3 < 9; i3 += 3) {
#pragma unroll
      for (int j = 0; j < 3; ++j) { const int ii = i3 + j; if (ii < 8) {
        const PrepIn& cur = ring[j];
        const int item = F.vcu * 8 + ii, h = item & 3, tok0 = (item >> 2) * 64;
        LAS float* tb = (LAS float*)(F.lds + MX_TB) + (ii & 1) * 320;
        float pb[2][4], bref[2][4], blast[2][4];
        gate_prefix(F, cur.ga, h, pb, tb);
        lbar();
        gate_finish(F, tb, pb, bref, blast);
#pragma unroll
        for (int q = 0; q < 2; ++q) { const size_t off = (size_t)(tok0 + 16 * mt + fr) * 256 + h * 64 + 16 * (nt0 + q) + 4 * fq;
            const float q0 = bflo(cur.q[q].x) * 0.125f, q1 = bfhi(cur.q[q].x) * 0.125f, q2 = bflo(cur.q[q].y) * 0.125f, q3 = bfhi(cur.q[q].y) * 0.125f;
            const float k0 = bflo(cur.k[q].x), k1 = bfhi(cur.k[q].x), k2 = bflo(cur.k[q].y), k3 = bfhi(cur.k[q].y);
            const float e0 = fexp(pb[q][0] - bref[q][0]), e1 = fexp(pb[q][1] - bref[q][1]), e2 = fexp(pb[q][2] - bref[q][2]), e3 = fexp(pb[q][3] - bref[q][3]);
            *(v2u*)(QT + off) = (v2u){pk2(q0 * e0, q1 * e1), pk2(q2 * e2, q3 * e3)};
            *(v2u*)(KT + off) = (v2u){pk2(k0 * fexp(bref[q][0] - pb[q][0]), k1 * fexp(bref[q][1] - pb[q][1])), pk2(k2 * fexp(bref[q][2] - pb[q][2]), k3 * fexp(bref[q][3] - pb[q][3]))};
            *(v2u*)(QH + off) = (v2u){pk2(q0 * fexp(pb[q][0]), q1 * fexp(pb[q][1])), pk2(q2 * fexp(pb[q][2]), q3 * fexp(pb[q][3]))};
            *(v2u*)(KH + off) = (v2u){pk2(k0 * fexp(blast[q][0] - pb[q][0]), k1 * fexp(blast[q][1] - pb[q][1])), pk2(k2 * fexp(blast[q][2] - pb[q][2]), k3 * fexp(blast[q][3] - pb[q][3]))};
            if (mt == 0 && fr == 0) *(f32x4*)(dec + item * 64 + 16 * (nt0 + q) + 4 * fq) = (f32x4){fexp(blast[q][0]), fexp(blast[q][1]), fexp(blast[q][2]), fexp(blast[q][3])}; }
        if (ii + 2 < 8) prep_load(F, item + 2, ring[(j + 2) % 3]);
      } }
    }
}

struct StateIn { v4u kh; v4u v; f32x4 dc; };
__device__ __forceinline__ void state_load(Frame& F, int b, int n, int h, int vq, StateIn& s) {
    const int fq = F.lane >> 4, ntk = F.wave & 3; const int tok0 = b * SEQ + 64 * n, item = (b * 32 + n) * 4 + h;
    s.kh = *(const v4u*)(gla_arr(F, 3) + (size_t)(tok0 + (F.tid >> 3)) * 256 + h * 64 + 8 * (F.tid & 7));
    const int c = F.tid & 255; s.v = *(const v4u*)(wsb(F, WS_P) + (size_t)(tok0 + (c >> 2)) * PNP + PC_V + h * 128 + 32 * vq + 8 * (c & 3));
    s.dc = *(const f32x4*)((const float*)(F.ws + WS_ROUTE + RT_DEC) + item * 64 + 16 * ntk + 4 * fq);
}
__device__ __forceinline__ void p3a_gla_state(Frame& F, int l, int var) {
    const int fr = F.lane & 15, fq = F.lane >> 4, w = F.wave, mtv = w >> 2, ntk = w & 3;
    const int b = F.vcu >> 4, h = (F.vcu >> 2) & 3, vq = F.vcu & 3;
    StateIn ring[6];
#pragma unroll
    for (int j = 0; j < 6; ++j) state_load(F, b, j, h, vq, ring[j]);
    f32x4 S = (f32x4){0.f, 0.f, 0.f, 0.f};
    const unsigned rq = (unsigned)(8 * fq + (fr >> 2)), cp = (unsigned)(4 * (fr & 3));
    const unsigned av = (unsigned)MS_VI + rq * 80u + (16u * mtv + cp) * 2u, ak = (unsigned)MS_KI + rq * (unsigned)P64 + (16u * ntk + cp) * 2u;
    bf16* kvo = (bf16*)F.out;
    __syncthreads();
    for (int n6 = 0; n6 < 36; n6 += 6) {
#pragma unroll
      for (int j = 0; j < 6; j += 2) { const int n = n6 + j; if (n < 32) {
        const unsigned sb = (unsigned)(((n >> 1) & 1) * 2 * MS_SET);
        *(LAS v4u*)(F.lds + sb + MS_KI + (F.tid >> 3) * P64 + (F.tid & 7) * 16) = ring[j].kh; *(LAS v4u*)(F.lds + sb + MS_KI + MS_SET + (F.tid >> 3) * P64 + (F.tid & 7) * 16) = ring[j + 1].kh;
        if (F.tid < 256) { *(LAS v4u*)(F.lds + sb + MS_VI + (F.tid >> 2) * 80 + (F.tid & 3) * 16) = ring[j].v; *(LAS v4u*)(F.lds + sb + MS_VI + MS_SET + (F.tid >> 2) * 80 + (F.tid & 3) * 16) = ring[j + 1].v; }
        const f32x4 d0 = ring[j].dc, d1 = ring[j + 1].dc;
        if (n + 6 < 32 && var != 1) { state_load(F, b, n + 6, h, vq, ring[j]); state_load(F, b, n + 7, h, vq, ring[j + 1]); }
        lbar();
        f32x4 kv0 = (f32x4){0.f, 0.f, 0.f, 0.f}, kv1 = kv0;
#pragma unroll
        for (int ks = 0; ks < 2; ++ks) { bf16x8 fa, fb; const unsigned oa = sb + ks * 32u * 80u, ob = sb + ks * 32u * (unsigned)P64;
            trfrag2(av + oa, av + oa + 4u * 80u, ak + ob, ak + ob + 4u * (unsigned)P64, fa, fb); kv0 = mma16(fa, fb, kv0);
            trfrag2(av + (unsigned)MS_SET + oa, av + (unsigned)MS_SET + oa + 4u * 80u, ak + (unsigned)MS_SET + ob, ak + (unsigned)MS_SET + ob + 4u * (unsigned)P64, fa, fb); kv1 = mma16(fa, fb, kv1); }
        const size_t o0 = (size_t)((b * 32 + n) * 4 + h) * 8192 + (32 * vq + 16 * mtv + fr) * 64 + 16 * ntk + 4 * fq;
        if (var != 2) *(v2u*)(kvo + o0) = (v2u){pk2(S[0], S[1]), pk2(S[2], S[3])};
        S = d0 * S + kv0;
        if (var != 2) *(v2u*)(kvo + o0 + 4 * 8192) = (v2u){pk2(S[0], S[1]), pk2(S[2], S[3])};
        S = d1 * S + kv1;
      } }
    }
}

constexpr int MO_BASE = 8192, MO_HALF = 71680;
constexpr int MO_QT = 0, MO_KT = 9216, MO_QH = 18432, MO_SC = 27648, MO_ST = 36864, MO_VI = 55296;
static_assert(MO_BASE + 2 * MO_HALF <= LDSCTL_OFF && ((MO_BASE + MO_VI) & 255) == 0 && (MO_HALF & 255) == 0, "mixer-out LDS");
struct OutIn { v4u qt[2], kt[2], qh[2]; v4u v[4]; v4u s[4]; };
__device__ __forceinline__ void out_load(Frame& F, int item, OutIn& o) {
    const int h = item & 3, tok0 = (item >> 2) * 64, t8 = F.tid & 255;
    const bf16* P = wsb(F, WS_P);
#pragma unroll
    for (int i = 0; i < 2; ++i) { const int c = t8 + 256 * i; const size_t go = (size_t)(tok0 + (c >> 3)) * 256 + h * 64 + 8 * (c & 7);
        o.qt[i] = __builtin_nontemporal_load((const v4u*)(gla_arr(F, 0) + go)); o.kt[i] = __builtin_nontemporal_load((const v4u*)(gla_arr(F, 1) + go)); o.qh[i] = __builtin_nontemporal_load((const v4u*)(gla_arr(F, 2) + go)); }
#pragma unroll
    for (int i = 0; i < 4; ++i) { const int c = t8 + 256 * i; o.v[i] = __builtin_nontemporal_load((const v4u*)(P + (size_t)(tok0 + (c >> 4)) * PNP + PC_V + h * 128 + 8 * (c & 15)));
        o.s[i] = __builtin_nontemporal_load((const v4u*)((const bf16*)F.out + (size_t)item * 8192 + (size_t)c * 8)); }
}
__device__ __forceinline__ void p3c_mixer_out(Frame& F, int l) {
    const int fr = F.lane & 15, fq = F.lane >> 4, w = F.wave, half = w >> 2, mt = w & 3, t8 = F.tid & 255;
    const bf16* P = wsb(F, WS_P); bf16* Y = wsb(F, WS_HY); unsigned char* Y8 = F.ws + WS_HY; const bool y8 = FP8_ON(l, 1);
    {
    LAS unsigned char* L = F.lds + MO_BASE + half * MO_HALF;
    const unsigned lvi = (unsigned)(MO_BASE + half * MO_HALF + MO_VI);
    OutIn cur;
    out_load(F, F.vcu * 8 + half, cur);
    const unsigned rq = (unsigned)(8 * fq + (fr >> 2)), ch0 = (unsigned)((fr & 3) >> 1), c8 = (unsigned)(8 * (fr & 1));
    __syncthreads();
    ((LAS float*)(F.lds + MX_GG))[F.tid] = F.inp[I_GLAG][l * 512 + F.tid];
    for (int it = 0; it < 4; ++it) {
      {
        const int item = F.vcu * 8 + 2 * it + half, h = item & 3, tok0 = (item >> 2) * 64;
        const int i = 16 * mt + fr;
        v2u ogv[8];
#pragma unroll
        for (int q = 0; q < 8; ++q) ogv[q] = *(const v2u*)(P + (size_t)(tok0 + i) * PNP + PC_OG + h * 128 + 16 * q + 4 * fq);
        lbar();
#pragma unroll
        for (int k = 0; k < 2; ++k) { const int c = t8 + 256 * k, to = (c >> 3) * P64 + (c & 7) * 16;
            *(LAS v4u*)(L + MO_QT + to) = cur.qt[k]; *(LAS v4u*)(L + MO_KT + to) = cur.kt[k]; *(LAS v4u*)(L + MO_QH + to) = cur.qh[k]; }
#pragma unroll
        for (int k = 0; k < 4; ++k) { const unsigned c = (unsigned)(t8 + 256 * k); *(LAS v4u*)(L + MO_VI + offb(c >> 4, c & 15)) = cur.v[k];
            *(LAS v4u*)(L + MO_ST + (c >> 3) * P64 + (c & 7) * 16) = cur.s[k]; }
        if (it + 1 < 4) out_load(F, item + 2, cur);
        lbar();
        {
          const bf16x8 a0 = ldfrag(L + MO_QT, P64, 16 * mt, 0, fr, fq), a1 = ldfrag(L + MO_QT, P64, 16 * mt, 32, fr, fq);
#pragma unroll
          for (int nt = 0; nt < 4; ++nt) { f32x4 c = (f32x4){0.f, 0.f, 0.f, 0.f};
              c = mma16(a0, ldfrag(L + MO_KT, P64, 16 * nt, 0, fr, fq), c); c = mma16(a1, ldfrag(L + MO_KT, P64, 16 * nt, 32, fr, fq), c);
              const int j0 = 16 * nt + 4 * fq;
              const float c0 = (j0 + 0 <= i) ? c[0] : 0.f, c1 = (j0 + 1 <= i) ? c[1] : 0.f, c2 = (j0 + 2 <= i) ? c[2] : 0.f, c3 = (j0 + 3 <= i) ? c[3] : 0.f;
              *(LAS v2u*)(L + MO_SC + i * P64 + 2 * j0) = (v2u){pk2(c0, c1), pk2(c2, c3)}; } }
        lbar();
        f32x4 acc[8];
#pragma unroll
        for (int q = 0; q < 8; ++q) acc[q] = (f32x4){0.f, 0.f, 0.f, 0.f};
#pragma unroll
        for (int ks = 0; ks < 2; ++ks) { const bf16x8 a1 = ldfrag(L + MO_SC, P64, 16 * mt, 32 * ks, fr, fq), a2 = ldfrag(L + MO_QH, P64, 16 * mt, 32 * ks, fr, fq);
            const unsigned r0 = 32u * ks + rq, r1 = r0 + 4u;
#pragma unroll
            for (int q = 0; q < 8; q += 2) { const unsigned cA = 2u * q + ch0, cB = cA + 2u; bf16x8 va, vb;
                trfrag2(lvi + offb(r0, cA) + c8, lvi + offb(r1, cA) + c8, lvi + offb(r0, cB) + c8, lvi + offb(r1, cB) + c8, va, vb);
                acc[q] = mma16(a1, va, acc[q]); acc[q + 1] = mma16(a1, vb, acc[q + 1]); }
#pragma unroll
            for (int q = 0; q < 8; ++q) acc[q] = mma16(a2, ldfrag(L + MO_ST, P64, 16 * q, 32 * ks, fr, fq), acc[q]); }
        float ss = 0.f;
#pragma unroll
        for (int q = 0; q < 8; ++q) ss += (acc[q][0] * acc[q][0] + acc[q][1] * acc[q][1]) + (acc[q][2] * acc[q][2] + acc[q][3] * acc[q][3]);
        ss += __shfl_xor(ss, 16); ss += __shfl_xor(ss, 32);
        const float rn = 1.0f / sqrtf(ss * (1.0f / 128.0f) + EPS);
#pragma unroll
        for (int q = 0; q < 8; ++q) { const int col = h * 128 + 16 * q + 4 * fq; const size_t tok = (size_t)(tok0 + i);
            const v2u og = ogv[q]; const f32x4 gg = *(const LAS f32x4*)(F.lds + MX_GG + col * 4);
            const float o0 = bflo(og.x), o1 = bfhi(og.x), o2 = bflo(og.y), o3 = bfhi(og.y);
            const float y0 = acc[q][0] * rn * gg[0] * o0 * __builtin_amdgcn_rcpf(1.0f + fexp(-o0)), y1 = acc[q][1] * rn * gg[1] * o1 * __builtin_amdgcn_rcpf(1.0f + fexp(-o1));
            const float y2 = acc[q][2] * rn * gg[2] * o2 * __builtin_amdgcn_rcpf(1.0f + fexp(-o2)), y3 = acc[q][3] * rn * gg[3] * o3 * __builtin_amdgcn_rcpf(1.0f + fexp(-o3));
            if (y8) *(unsigned*)(Y8 + tok * DM + 256 + col) = pk4f8(y0 * Y8S, y1 * Y8S, y2 * Y8S, y3 * Y8S); else *(v2u*)(Y + tok * DM + 256 + col) = (v2u){pk2(y0, y1), pk2(y2, y3)}; }
      }
    }
    }
    const int tokb = F.vcu * 128;
    __syncthreads();
    const bf16* GWp = wsb(F, WS_GW) + (size_t)l * 4 * 128 * 128; const int gt = 16 * w + fr;
    bf16x8 gaw[4][4]; v2u guu[4][4]; float gbs[4];
    {
      const f32x4 lg4 = *(const f32x4*)(F.inp[I_LNG] + l * 256 + 4 * F.lane), lb4 = *(const f32x4*)(F.inp[I_LNB] + l * 256 + 4 * F.lane);
      v2u xin[16];
#pragma unroll
      for (int i = 0; i < 16; ++i) xin[i] = *(const v2u*)(P + (size_t)(tokb + 16 * w + i) * PNP + PC_VV + 4 * F.lane);
#pragma unroll
      for (int h = 0; h < 4; ++h) { gbs[h] = F.inp[I_GBS][(l * 4 + h) * 128 + gt];
#pragma unroll
          for (int ks = 0; ks < 4; ++ks) gaw[h][ks] = *(const bf16x8*)(GWp + ((size_t)h * 128 + gt) * 128 + 32 * ks + 8 * fq);
#pragma unroll
          for (int q = 0; q < 4; ++q) guu[h][q] = *(const v2u*)(P + (size_t)(tokb + gt) * PNP + PC_U + h * 64 + 16 * q + 4 * fq); }
      unsigned o[4][8];
#pragma unroll
      for (int i = 0; i < 16; i += 2) { float y[2][4];
#pragma unroll
          for (int e = 0; e < 2; ++e) { float x[4] = {bflo(xin[i + e].x), bfhi(xin[i + e].x), bflo(xin[i + e].y), bfhi(xin[i + e].y)};
              const float mu = wave_sum((x[0] + x[1]) + (x[2] + x[3])) * (1.0f / 256.0f); float vr = 0.f;
#pragma unroll
              for (int q = 0; q < 4; ++q) { x[q] -= mu; vr += x[q] * x[q]; }
              const float rs = 1.0f / sqrtf(wave_sum(vr) * (1.0f / 256.0f) + EPS);
#pragma unroll
              for (int q = 0; q < 4; ++q) y[e][q] = x[q] * rs * lg4[q] + lb4[q]; }
#pragma unroll
          for (int q = 0; q < 4; ++q) o[q][i >> 1] = pk2(y[0][q], y[1][q]); }
#pragma unroll
      for (int q = 0; q < 4; ++q) { LAS unsigned char* d = F.lds + MX_VN + (4 * F.lane + q) * P128 + 32 * w;
          *(LAS v4u*)d = (v4u){o[q][0], o[q][1], o[q][2], o[q][3]}; *(LAS v4u*)(d + 16) = (v4u){o[q][4], o[q][5], o[q][6], o[q][7]}; } }
    __syncthreads();
    { const size_t tok = (size_t)(tokb + gt);
      const int nks = (w < 4) ? 2 : 4;
#pragma unroll
      for (int h = 0; h < 4; ++h) {
          f32x4 acc[4];
#pragma unroll
          for (int q = 0; q < 4; ++q) acc[q] = (f32x4){0.f, 0.f, 0.f, 0.f};
#pragma unroll
          for (int ks = 0; ks < 4; ++ks) { if (ks < nks) {
#pragma unroll
              for (int q = 0; q < 4; ++q) acc[q] = mma16(gaw[h][ks], ldfrag(F.lds + MX_VN, P128, h * 64 + 16 * q, 32 * ks, fr, fq), acc[q]); } }
          const float bs = gbs[h];
#pragma unroll
          for (int q = 0; q < 4; ++q) { const int c = h * 64 + 16 * q + 4 * fq; const v2u u = guu[h][q];
              const float a0 = bflo(u.x) * (acc[q][0] + bs), a1 = bfhi(u.x) * (acc[q][1] + bs), a2 = bflo(u.y) * (acc[q][2] + bs), a3 = bfhi(u.y) * (acc[q][3] + bs);
              if (y8) *(unsigned*)(Y8 + tok * DM + c) = pk4f8(a0 * Y8S, a1 * Y8S, a2 * Y8S, a3 * Y8S); else *(v2u*)(Y + tok * DM + c) = (v2u){pk2(a0, a1), pk2(a2, a3)}; }
      } }
    { const int c = (F.tid & 31) * 8, tg = F.tid >> 5;
      float cw0[8], cw1[8], cw2[8], cbb[8];
#pragma unroll
      for (int e = 0; e < 8; ++e) { const float* cw = F.inp[I_CONVW] + l * 3 * 256 + c + e; cw0[e] = cw[0]; cw1[e] = cw[256]; cw2[e] = cw[512]; cbb[e] = F.inp[I_CONVB][l * 256 + c + e]; }
      const size_t tok0 = (size_t)(tokb + 8 * tg); const int tseq0 = (int)(tok0 & (SEQ - 1));
      v4u ca[10], cxv[10], gbv[8];
#pragma unroll
      for (int j = 0; j < 10; ++j) { const bool ok = (j >= 2) || (tseq0 + j - 2 >= 0);
          if (ok) { ca[j] = *(const v4u*)(P + (tok0 + j - 2) * PNP + PC_CC + c); cxv[j] = *(const v4u*)(P + (tok0 + j - 2) * PNP + PC_CX + c); }
          else { ca[j] = (v4u){0u, 0u, 0u, 0u}; cxv[j] = (v4u){0u, 0u, 0u, 0u}; } }
#pragma unroll
      for (int k = 0; k < 8; ++k) gbv[k] = __builtin_nontemporal_load((const v4u*)(P + (tok0 + k) * PNP + PC_CB + c));
      float z[10][8];
#pragma unroll
      for (int j = 0; j < 10; ++j) { const v4u a = ca[j], x = cxv[j];
          z[j][0] = bflo(a.x) * bflo(x.x); z[j][1] = bfhi(a.x) * bfhi(x.x); z[j][2] = bflo(a.y) * bflo(x.y); z[j][3] = bfhi(a.y) * bfhi(x.y);
          z[j][4] = bflo(a.z) * bflo(x.z); z[j][5] = bfhi(a.z) * bfhi(x.z); z[j][6] = bflo(a.w) * bflo(x.w); z[j][7] = bfhi(a.w) * bfhi(x.w); }
#pragma unroll
      for (int k = 0; k < 8; ++k) { const size_t tok = tok0 + k; const v4u gb = gbv[k];
        const float cbv[8] = {bflo(gb.x), bfhi(gb.x), bflo(gb.y), bfhi(gb.y), bflo(gb.z), bfhi(gb.z), bflo(gb.w), bfhi(gb.w)};
        float y[8];
#pragma unroll
        for (int e = 0; e < 8; ++e) y[e] = cbv[e] * (cbb[e] + cw0[e] * z[k][e] + cw1[e] * z[k + 1][e] + cw2[e] * z[k + 2][e]);
        if (y8) *(v2u*)(Y8 + tok * DM + 768 + c) = (v2u){pk4f8(y[0] * Y8S, y[1] * Y8S, y[2] * Y8S, y[3] * Y8S), pk4f8(y[4] * Y8S, y[5] * Y8S, y[6] * Y8S, y[7] * Y8S)};
        else *(v4u*)(Y + tok * DM + 768 + c) = (v4u){pk2(y[0], y[1]), pk2(y[2], y[3]), pk2(y[4], y[5]), pk2(y[6], y[7])}; } }
}
constexpr int LT_CNT = 0, LT_BASE = 32, LT_SEG = 64, LT_REC = 128, LT_TILE = 1280, LT_ROW = 1664;
static_assert(LTAB_OFF + (LT_ROW + 5 * 256) * 4 <= LDSCTL_OFF, "LTAB");
__device__ __forceinline__ void norm2_vectors(Frame& F, int l, int b, f32x4 (&gs)[4], f32x4 (&sh)[4]) {
    const float* mod = modp(F, l) + b * 6144;
#pragma unroll
    for (int j = 0; j < 4; ++j) { const int c = 4 * F.lane + 256 * j; const f32x4 g4 = *(const f32x4*)(F.inp[I_GN2] + l * DM + c), s4 = *(const f32x4*)(mod + 4096 + c);
        gs[j] = g4 * (s4 + 1.0f); sh[j] = *(const f32x4*)(mod + 3072 + c); }
}
__device__ __forceinline__ void load_xrow(const bf16* X, size_t row, int lane, f32x4 (&v)[4]) {
#pragma unroll
    for (int j = 0; j < 4; ++j) { const v2u xv = *(const v2u*)(X + row * DM + 4 * lane + 256 * j); v[j] = (f32x4){bflo(xv.x), bfhi(xv.x), bflo(xv.y), bfhi(xv.y)}; }
}
constexpr int RW_PITCH = 2064;
constexpr int R_GS = 32 * RW_PITCH, R_SH = R_GS + 4096, R_LG = R_SH + 4096, R_RS = R_LG + 128 * 33 * 4, R_END = R_RS + 512;
static_assert(R_END <= LTAB_OFF, "router LDS");
__device__ __forceinline__ void p5a_route(Frame& F, int l, int cslot  ) {
    LAS unsigned* lt = (LAS unsigned*)(F.lds + LTAB_OFF);
    LAS float* gsl = (LAS float*)(F.lds + R_GS); LAS float* shl = (LAS float*)(F.lds + R_SH); LAS float* lgl = (LAS float*)(F.lds + R_LG); LAS float* rsl = (LAS float*)(F.lds + R_RS);
    const int tokb = F.vcu * 128, b = tokb >> 11, fr = F.lane & 15, fq = F.lane >> 4; const bf16* X = wsb(F, WS_X);
    __syncthreads();
    { const v4u* src = (const v4u*)(F.ws + WS_WR);
#pragma unroll
      for (int i = 0; i < 8; ++i) { const int c = F.tid + 512 * i; *(LAS v4u*)(F.lds + (c >> 7) * RW_PITCH + (c & 127) * 16) = src[c]; }
      const float* mod = modp(F, l) + b * 6144;
      for (int k = F.tid; k < DM; k += 512) { gsl[k] = F.inp[I_GN2][l * DM + k] * (mod[4096 + k] + 1.0f); shl[k] = mod[3072 + k]; }
      if (F.tid < 32) lt[LT_CNT + F.tid] = 0u; }
    __syncthreads();
    float myrs = 0.f;
    for (int i = 0; i < 16; i += 4) { f32x4 v0[4], v1[4], v2[4], v3[4];
        load_xrow(X, (size_t)(tokb + 16 * F.wave + i), F.lane, v0); load_xrow(X, (size_t)(tokb + 16 * F.wave + i + 1), F.lane, v1);
        load_xrow(X, (size_t)(tokb + 16 * F.wave + i + 2), F.lane, v2); load_xrow(X, (size_t)(tokb + 16 * F.wave + i + 3), F.lane, v3);
        const float r0 = row_rstd(v0), r1 = row_rstd(v1), r2 = row_rstd(v2), r3 = row_rstd(v3);
        myrs = (fr == i) ? r0 : (fr == i + 1) ? r1 : (fr == i + 2) ? r2 : (fr == i + 3) ? r3 : myrs; }
    if (fq == 0) rsl[16 * F.wave + fr] = myrs;
    f32x4 acc0 = (f32x4){0.f, 0.f, 0.f, 0.f}, acc1 = acc0;
    const bf16* xr = X + (size_t)(tokb + 16 * F.wave + fr) * DM + 8 * fq;
#pragma unroll 4
    for (int ks = 0; ks < 32; ++ks) { const v4u xv = *(const v4u*)(xr + 32 * ks); const int k0 = 32 * ks + 8 * fq;
        const f32x4 g0 = *(const LAS f32x4*)(gsl + k0), g1 = *(const LAS f32x4*)(gsl + k0 + 4), s0 = *(const LAS f32x4*)(shl + k0), s1 = *(const LAS f32x4*)(shl + k0 + 4);
        v4u hv;
        hv.x = pk2(bflo(xv.x) * myrs * g0[0] + s0[0], bfhi(xv.x) * myrs * g0[1] + s0[1]); hv.y = pk2(bflo(xv.y) * myrs * g0[2] + s0[2], bfhi(xv.y) * myrs * g0[3] + s0[3]);
        hv.z = pk2(bflo(xv.z) * myrs * g1[0] + s1[0], bfhi(xv.z) * myrs * g1[1] + s1[1]); hv.w = pk2(bflo(xv.w) * myrs * g1[2] + s1[2], bfhi(xv.w) * myrs * g1[3] + s1[3]);
        if (FP8_ON(l, 2)) *(v2u*)((unsigned char*)(F.ws + WS_H2) + (size_t)(tokb + 16 * F.wave + fr) * DM + k0) = (v2u){pk4f8(bflo(hv.x), bfhi(hv.x), bflo(hv.y), bfhi(hv.y)), pk4f8(bflo(hv.z), bfhi(hv.z), bflo(hv.w), bfhi(hv.w))};
        else *(v4u*)(wsb(F, WS_H2) + (size_t)(tokb + 16 * F.wave + fr) * DM + k0) = hv;
        const bf16x8 a = __builtin_bit_cast(bf16x8, hv);
        acc0 = mma16(a, ldfrag(F.lds, RW_PITCH, 0, 32 * ks, fr, fq), acc0); acc1 = mma16(a, ldfrag(F.lds, RW_PITCH, 16, 32 * ks, fr, fq), acc1); }
    { LAS float* lr = lgl + (16 * F.wave + fr) * 33 + 4 * fq;
      lr[0] = acc0[0]; lr[1] = acc0[1]; lr[2] = acc0[2]; lr[3] = acc0[3]; lr[16] = acc1[0]; lr[17] = acc1[1]; lr[18] = acc1[2]; lr[19] = acc1[3]; }
    __syncthreads();
    if (F.tid < 128) {
        float lg[32]; float mx = -3.0e38f;
#pragma unroll
        for (int e = 0; e < 32; ++e) { lg[e] = lgl[F.tid * 33 + e] + F.inp[I_RB][e]; mx = fmaxf(mx, lg[e]); }
#pragma unroll
        for (int e = 0; e < 32; ++e) lg[e] = __expf(lg[e] - mx);
        float bt1 = 0.f, bt2 = 0.f, bgs = -1.f; int bi1 = 0, bi2 = 0, bg = 0;
#pragma unroll
        for (int g = 0; g < 4; ++g) { float t1 = -1.f, t2 = -1.f; int i1 = 0, i2 = 0;
#pragma unroll
            for (int i = 0; i < 8; ++i) { const float v = lg[8 * g + i];
                if (v > t1) { t2 = t1; i2 = i1; t1 = v; i1 = i; } else if (v > t2) { t2 = v; i2 = i; } }
            const float sc = t1 + t2;
            if (sc > bgs) { bgs = sc; bg = g; bt1 = t1; bt2 = t2; bi1 = i1; bi2 = i2; } }
        const int e0 = 8 * bg + bi1, e1 = 8 * bg + bi2; const float inv = 1.0f / (bt1 + bt2);
        const unsigned r0 = __hip_atomic_fetch_add(&lt[LT_CNT + e0], 1u, __ATOMIC_RELAXED, __HIP_MEMORY_SCOPE_WORKGROUP), r1 = __hip_atomic_fetch_add(&lt[LT_CNT + e1], 1u, __ATOMIC_RELAXED, __HIP_MEMORY_SCOPE_WORKGROUP);
        LAS unsigned* rec = lt + LT_REC + 8 * F.tid;
        rec[0] = (unsigned)(e0 | (e1 << 8)); rec[1] = r0; rec[2] = r1; rec[3] = __float_as_uint(bt1 * inv); rec[4] = __float_as_uint(bt2 * inv); rec[5] = __float_as_uint(rsl[F.tid]);
    }
    __syncthreads();
    if (F.tid < 32) lt[LT_BASE + F.tid] = __hip_atomic_fetch_add((unsigned*)(F.ws + WS_CTL) + CW_CNT + 64 * cslot + F.tid, lt[LT_CNT + F.tid], RLX_AGENT);
    __syncthreads();
    if (F.tid < 128) { const LAS unsigned* rec = lt + LT_REC + 8 * F.tid; const int tok = tokb + F.tid; const unsigned ee = rec[0]; const int e0 = ee & 255, e1 = ee >> 8;
        int* list = (int*)(F.ws + WS_LIST);
        list[e0 * NTOK + (int)(lt[LT_BASE + e0] + rec[1])] = tok; list[e1 * NTOK + (int)(lt[LT_BASE + e1] + rec[2])] = NTOK + tok;
        unsigned* rw = (unsigned*)(F.ws + WS_ROUTE + RT_W); rw[2 * tok] = rec[3]; rw[2 * tok + 1] = rec[4]; }
}
__device__ __forceinline__ void moe_tables(Frame& F, int l) {
    LAS unsigned* lt = (LAS unsigned*)(F.lds + LTAB_OFF);
    __syncthreads();
    if (F.tid < 32) {
        const unsigned cnt = __hip_atomic_load((unsigned*)(F.ws + WS_CTL) + CW_CNT + 64 * l + F.tid, RLX_AGENT), pad = (cnt + 255u) & ~255u;
        unsigned inc = pad;
#pragma unroll
        for (int d = 1; d < 32; d <<= 1) { const unsigned t = __shfl_up(inc, d); if (F.tid >= d) inc += t; }
        const unsigned seg = inc - pad;
        lt[LT_CNT + F.tid] = cnt; lt[LT_SEG + F.tid] = seg; if (F.tid == 31) lt[LT_SEG + 32] = inc;
        for (unsigned t = seg >> 8; t < (inc >> 8); ++t) lt[LT_TILE + t] = (unsigned)F.tid; }
    __syncthreads();
    const int* list = (const int*)(F.ws + WS_LIST); const int ntiles = (int)(lt[LT_SEG + 32] >> 8);
    int rv[3];
#pragma unroll
    for (int q = 0; q < 3; ++q) { const int idx = F.tid + 512 * q, ord = idx >> 8, r = idx & 255, tile = (ord * F.G + F.vcu) >> 2; rv[q] = DUMMY_ROW;
        if (idx < 5 * 256 && tile < ntiles) { const int e = (int)lt[LT_TILE + tile], pos = 256 * (tile - (int)(lt[LT_SEG + e] >> 8)) + r; if (pos < (int)lt[LT_CNT + e]) rv[q] = list[e * NTOK + pos]; } }
#pragma unroll
    for (int q = 0; q < 3; ++q) { const int idx = F.tid + 512 * q; if (idx < 5 * 256) lt[LT_ROW + idx] = (unsigned)rv[q]; }
    __syncthreads();
}
template <bool GATHER_> struct GroupedOrder {
    static constexpr bool GATHER = GATHER_;
    __device__ __forceinline__ unsigned arow(int ord, int row, int K) const { return (lt[LT_ROW + ord * 256 + row] & 32767u) * (unsigned)(K * 2); }
    const LAS unsigned* lt; int vcu, G, bstride;
    __device__ __forceinline__ bool next(int i, pg8::Unit& u) const {
        const int L = i * G + vcu, tile = L >> 2; if (tile >= (int)(lt[LT_SEG + 32] >> 8)) return false;
        u.pm = tile; u.pn = L & 3; u.bo = (int)lt[LT_TILE + tile] * bstride; u.ui = i; return true;
    }
    __device__ __forceinline__ void a_ready(const pg8::Unit&) const {}
    __device__ __forceinline__ void done(const pg8::Unit&) const {}
};
#ifndef DUP_PH
#define DUP_PH (-1)
#endif
#ifndef DUP_N
#define DUP_N 1
#endif
#ifndef DUP_VAR
#define DUP_VAR 0
#endif
struct Args { const float* in[23]; float* out; unsigned char* ws; int ph_lo, ph_hi; };
__global__ void __launch_bounds__(NWAVES * 64, 2) mk_fwd(Args args) {
    extern __shared__ __attribute__((aligned(16))) unsigned char lds[];
    Frame F;
    F.lds = (LAS unsigned char*)lds;
    F.tid = threadIdx.x; F.lane = F.tid & 63; F.wave = __builtin_amdgcn_readfirstlane(F.tid >> 6);
    int wave0 = F.wave; asm volatile("" : "+s"(wave0));
    F.G = gridDim.x; { const int bx = blockIdx.x; F.vcu = (F.G % 8 == 0) ? (bx % 8) * (F.G / 8) + bx / 8 : bx; }
    F.inp = (KArgPtr)__builtin_amdgcn_kernarg_segment_ptr();
    F.out = args.out; F.ws = args.ws;
    volatile LAS unsigned* MISC = (volatile LAS unsigned*)(F.lds + LDSCTL_OFF);
    for (int u = F.tid; u < (LDS_BYTES - LDSCTL_OFF) / 4; u += NWAVES * 64) MISC[u] = 0u;
    __syncthreads();
    const int lo = args.ph_lo, hi = args.ph_hi;
    XcdBarrier bar; bar.bar = (unsigned*)(F.ws + WS_CTL) + CW_BAR; bar.x = 0; bar.st = nullptr;
    if (hi - lo > 1) bar = xcd_barrier_post((unsigned*)(F.ws + WS_CTL) + CW_BAR, MISC + 8);
#ifdef P0_EXTRA
    for (int q = 0; q < P0_EXTRA; ++q) { p0_prologue(F, P0_VAR); xcd_barrier(bar, F.tid == 0); }
#endif
    for (int ph = lo; ph < hi; ++ph) {
        int w0 = wave0; unsigned ones = ~0u; asm volatile("" : "+s"(w0), "+s"(ones));
        int tid = w0 * 64 + (int)__builtin_amdgcn_mbcnt_hi(ones, __builtin_amdgcn_mbcnt_lo(ones, 0u)); asm volatile("" : "+v"(tid));
        { KArgPtr kp = (KArgPtr)__builtin_amdgcn_kernarg_segment_ptr(); asm volatile("" : "+s"(kp)); F.inp = kp; }
        F.tid = tid; F.lane = tid & 63; F.wave = __builtin_amdgcn_readfirstlane(tid >> 6);
        const int pe = (DUP_PH >= 0 && ph > DUP_PH) ? ((ph - DUP_N > DUP_PH) ? ph - DUP_N : DUP_PH) : ph;
        const int l = (pe >= 2) ? (pe - 2) / 9 : 0, kind = (pe >= 2) ? 2 + (pe - 2) % 9 : pe;
        if (kind == 0) p0_prologue(F, 0);
        else if (kind == 1) p1_first_norm(F);
        else if (kind == 2) {
            pg8::Gemm g{wsb(F, WS_HY), wsb(F, WS_WIN) + (size_t)l * PNP * DM, NTOK, PNP, DM}; pg8::StaticOrder S; S.init(NTOK, PNP, F.G, (int)blockIdx.x);
            pg8::EpiInProj E{wsb(F, WS_P), PNP, nullptr, 0.f};
            if (I8_ON(l)) { pg8::Gemm g8{h8p(F), wsb(F, WS_WIN) + (size_t)l * PNP * DM, NTOK, PNP, DM / 2}; pg8::EpiInProj Ei{wsb(F, WS_P), PNP, hsp(F), 1.0f / WI8S};
                pg8::gemm_phase<pg8::EpiInProj, pg8::StaticOrder, true, true, 0, 0, true>(F.lds, g8, S, Ei, tid); }
            else if (FP8_ON(l, 0)) { pg8::Gemm g8{h8p(F), wsb(F, WS_WIN) + (size_t)l * PNP * DM, NTOK, PNP, DM / 2}; pg8::gemm_phase<pg8::EpiInProj, pg8::StaticOrder, false, true, E8_ONE, E8_W>(F.lds, g8, S, E, tid); }
            else pg8::gemm_phase<pg8::EpiInProj, pg8::StaticOrder, true, true>(F.lds, g, S, E, tid); }
        else if (kind == 3) p3p_gla_prep(F, l);
        else if (kind == 4) p3a_gla_state(F, l, (DUP_PH >= 0 && ph >= DUP_PH && ph < DUP_PH + DUP_N) ? DUP_VAR : 0);
        else if (kind == 5) p3c_mixer_out(F, l);
        else if (kind == 6) {
            pg8::Gemm g{wsb(F, WS_HY), wsb(F, WS_WOUT) + (size_t)l * DM * DM, NTOK, DM, DM}; pg8::StaticOrder S; S.init(NTOK, DM, F.G, (int)blockIdx.x);
            const bool dry = (DUP_PH >= 0 && ph >= DUP_PH && ph < DUP_PH + DUP_N);
            pg8::EpiResid E{wsb(F, WS_X), modp(F, l) + 2048, dry ? wsb(F, WS_P) : wsb(F, WS_X)};
            if (FP8_ON(l, 1)) { pg8::Gemm g8{wsb(F, WS_HY), wsb(F, WS_WOUT) + (size_t)l * DM * DM, NTOK, DM, DM / 2}; pg8::gemm_phase<pg8::EpiResid, pg8::StaticOrder, true, true, E8_Y, E8_W>(F.lds, g8, S, E, tid); }
            else pg8::gemm_phase<pg8::EpiResid, pg8::StaticOrder, true, true>(F.lds, g, S, E, tid); }
        else if (kind == 7) p5a_route(F, l, (DUP_PH >= 0 && ph > DUP_PH && ph <= DUP_PH + DUP_N) ? l + 2 : l);
        else if (kind == 8) {
            moe_tables(F, l);
            pg8::Gemm g{wsb(F, WS_H2), wsb(F, WS_W13) + (size_t)l * NEXP * DM * DM, MAXSLOT, DM, DM};
            GroupedOrder<true> S{(const LAS unsigned*)(F.lds + LTAB_OFF), F.vcu, F.G, DM * DM};
            pg8::Gemm g8{wsb(F, WS_H2), wsb(F, WS_W13) + (size_t)l * NEXP * DM * DM, MAXSLOT, DM, DM / 2};
            pg8::EpiSwiGLU8 E8{F.ws + WS_HID, H8S}; pg8::EpiSwiGLU E{wsb(F, WS_HID)};
            if (FP8_ON(l, 2)) { if (FP8_ON(l, 3)) pg8::gemm_phase<pg8::EpiSwiGLU8, GroupedOrder<true>, true, true, E8_ONE, E8_W>(F.lds, g8, S, E8, tid);
                                else pg8::gemm_phase<pg8::EpiSwiGLU, GroupedOrder<true>, true, true, E8_ONE, E8_W>(F.lds, g8, S, E, tid); }
            else { if (FP8_ON(l, 3)) pg8::gemm_phase<pg8::EpiSwiGLU8, GroupedOrder<true>, true, true>(F.lds, g, S, E8, tid);
                   else pg8::gemm_phase<pg8::EpiSwiGLU, GroupedOrder<true>, true, true>(F.lds, g, S, E, tid); } }
        else if (kind == 9) {
            pg8::Gemm g{wsb(F, WS_HID), wsb(F, WS_W2) + (size_t)l * NEXP * DM * DFF, MAXSLOT, DM, DFF};
            GroupedOrder<false> S{(const LAS unsigned*)(F.lds + LTAB_OFF), F.vcu, F.G, DM * DFF};
#if YE_FP8
            typedef pg8::EpiScatter8 EpiY; EpiY E{F.ws + WS_YE, (const LAS int*)(F.lds + LTAB_OFF) + LT_ROW, E8S};
#else
            typedef pg8::EpiScatter EpiY; EpiY E{wsb(F, WS_YE), (const LAS int*)(F.lds + LTAB_OFF) + LT_ROW};
#endif
            if (FP8_ON(l, 3)) { pg8::Gemm g8{wsb(F, WS_HID), wsb(F, WS_W2) + (size_t)l * NEXP * DM * DFF, MAXSLOT, DM, DFF / 2};
                pg8::gemm_phase<EpiY, GroupedOrder<false>, true, true, E8_H, E8_W>(F.lds, g8, S, E, tid); }
            else pg8::gemm_phase<EpiY, GroupedOrder<false>, true, true>(F.lds, g, S, E, tid); }
        else p9_combine(F, l, (DUP_PH >= 0 && ph >= DUP_PH && ph < DUP_PH + DUP_N));
        if (ph + 1 < hi) xcd_barrier(bar, tid == 0, DUP_PH < 0 && ph >= 1 && kind != 7 && kind != 9);
    }
}

extern "C" void kernel_launch(void* const* d_in, const int* in_sizes, int n_in, void* d_out, int out_size, void* d_ws, size_t ws_size, hipStream_t stream) {
    static int grid = 0;
    if (grid == 0) {
        if (n_in != 23 || in_sizes[0] != NTOK * DM || out_size != NTOK * DM || ws_size < WS_END) {
            fprintf(stderr, "kernel_launch: unexpected problem (n_in %d, in0 %d, out %d, ws %zu; need ws >= %zu); nothing launched\n", n_in, n_in > 0 ? in_sizes[0] : -1, out_size, ws_size, (size_t)WS_END); grid = -1; return; }
        int dev = 0, cus = 0, per_cu = 0;
        if (hipGetDevice(&dev) != hipSuccess || hipDeviceGetAttribute(&cus, hipDeviceAttributeMultiprocessorCount, dev) != hipSuccess) { grid = -1; return; }
        if (hipFuncSetAttribute((const void*)mk_fwd, hipFuncAttributeMaxDynamicSharedMemorySize, LDS_BYTES) != hipSuccess) { fprintf(stderr, "kernel_launch: hipFuncSetAttribute failed\n"); grid = -1; return; }
        if (hipOccupancyMaxActiveBlocksPerMultiprocessor(&per_cu, (const void*)mk_fwd, NWAVES * 64, LDS_BYTES) != hipSuccess || per_cu < 1)
            fprintf(stderr, "kernel_launch: note: occupancy query reports %d workgroups per CU\n", per_cu);
        (void)hipGetLastError();
        grid = cus;
        if (grid != 256) fprintf(stderr, "kernel_launch: %d CUs; the phase bodies assume 256 workgroups\n", grid);
    }
    if (grid < 0) return;
    if (hipMemsetAsync((char*)d_ws + WS_CTL, 0, CTL_ZERO_BYTES, stream) != hipSuccess) { fprintf(stderr, "kernel_launch: memset failed\n"); return; }
    Args a{};
    for (int i = 0; i < 23; ++i) a.in[i] = (const float*)d_in[i];
    a.out = (float*)d_out; a.ws = (unsigned char*)d_ws;
    if (MK_N_LAUNCHES == 1) { a.ph_lo = 0; a.ph_hi = NPHASES + (DUP_PH >= 0 ? DUP_N : 0); hipLaunchKernelGGL(mk_fwd, dim3(grid), dim3(NWAVES * 64), LDS_BYTES, stream, a); }
    else for (int p = 0; p < NPHASES; ++p) { a.ph_lo = p; a.ph_hi = p + 1; hipLaunchKernelGGL(mk_fwd, dim3(grid), dim3(NWAVES * 64), LDS_BYTES, stream, a); }
    const hipError_t le = hipPeekAtLastError();
    if (le != hipSuccess) fprintf(stderr, "kernel_launch: launch failed: %s\n", hipGetErrorName(le));
}
```
